# Optimizing an MI355X kernel written in HIP

```python
import math
import jax, jax.numpy as jnp
from jax import lax
import numpy as np

D_MODEL = 1024
BATCH = 4
SEQ = 4096
DEPTH = 4
DEC_BATCH = 16
DEC_SEQ = 64
PAST_LEN = 1024

CHUNK = 64
N_MIXERS = 3
N_RG = (DEPTH + 2) // 3
N_SWA = (DEPTH + 1) // 3
N_FOX = DEPTH // 3
D_FF = 4 * D_MODEL
HEAD_DIM = 64
N_HEADS = D_MODEL // HEAD_DIM
SWA_KV_HEADS = 4
SWA_GROUP = N_HEADS // SWA_KV_HEADS
WINDOW = 128
WIN_CHUNKS = WINDOW // CHUNK
FOX_Q_BLOCK = 128
LRU_WIDTH = D_MODEL
LRU_BLOCKS = 4
LRU_BLOCK_W = LRU_WIDTH // LRU_BLOCKS
CONV_WIDTH = 4
LRU_C = 8.0
N_BUCKETS = 32
MAX_DISTANCE = 128
ALPHA = (2.0 * DEPTH) ** 0.25
BETA = (8.0 * DEPTH) ** -0.25
LN_EPS = 1e-5
ATTN_SCALE = HEAD_DIM ** -0.5

kernel_name = "hybrid_streaming_encoder_step"


def layer_norm(x, g, b):
    xf = x.astype(jnp.float32)
    mu = jnp.mean(xf, axis=-1, keepdims=True)
    var = jnp.mean(jnp.square(xf - mu), axis=-1, keepdims=True)
    return ((xf - mu) * lax.rsqrt(var + LN_EPS) * g.astype(jnp.float32) + b.astype(jnp.float32)).astype(x.dtype)


def sq_relu_mlp(x, w_up, w_down):
    return jnp.square(jax.nn.relu(x @ w_up)) @ w_down


def _linear_combine(e1, e2):
    a1, b1 = e1
    a2, b2 = e2
    return a1 * a2, a2 * b1 + b2


def rglru_mixer(x, conv_buf, h0, w_in, conv_w, conv_b, gate_w, gate_b, lam, w_out):
    B, T, _ = x.shape
    gate, u = jnp.split(x @ w_in, 2, axis=-1)
    u_pad = jnp.concatenate([conv_buf.astype(u.dtype), u], axis=1)
    conv = conv_b + u_pad[:, 0:T] * conv_w[0]
    for k in range(1, CONV_WIDTH):
        conv = conv + u_pad[:, k:k + T] * conv_w[k]
    new_buf = u_pad[:, T:]
    gates = jnp.einsum('btnd,nde->btne', conv.reshape(B, T, LRU_BLOCKS, LRU_BLOCK_W), gate_w) + gate_b
    gates = jax.nn.sigmoid(gates.astype(jnp.float32))
    r = gates[..., :LRU_BLOCK_W].reshape(B, T, LRU_WIDTH)
    i_g = gates[..., LRU_BLOCK_W:].reshape(B, T, LRU_WIDTH)
    log_a = -LRU_C * r * jax.nn.softplus(-lam.astype(jnp.float32))
    a = jnp.exp(log_a)
    b = jnp.sqrt(-jnp.expm1(2.0 * log_a)) * (i_g * conv.astype(jnp.float32))
    a_cum, b_cum = lax.associative_scan(_linear_combine, (a, b), axis=1)
    h = a_cum * h0.astype(jnp.float32)[:, None, :] + b_cum
    y = (h.astype(x.dtype) * jax.nn.gelu(gate)) @ w_out
    return y, new_buf, h[:, -1].astype(x.dtype)


def t5_relative_bias(rel, table):
    half = N_BUCKETS // 2
    max_exact = half // 2
    n = jnp.abs(rel)
    n_f = jnp.maximum(n, 1).astype(jnp.float32)
    large = max_exact + (jnp.log(n_f / max_exact) / math.log(MAX_DISTANCE / max_exact) * (half - max_exact)).astype(jnp.int32)
    large = jnp.minimum(large, half - 1)
    bucket = jnp.where(rel > 0, half, 0) + jnp.where(n < max_exact, n, large)
    return jnp.transpose(table[bucket].astype(jnp.float32), (2, 0, 1))


def swa_project(x, w_qkv):
    B, T, _ = x.shape
    hq = N_HEADS * HEAD_DIM
    hk = SWA_KV_HEADS * HEAD_DIM
    qkv = x @ w_qkv
    q = qkv[..., :hq].reshape(B, T, SWA_KV_HEADS, SWA_GROUP, HEAD_DIM)
    k = qkv[..., hq:hq + hk].reshape(B, T, SWA_KV_HEADS, HEAD_DIM)
    v = qkv[..., hq + hk:].reshape(B, T, SWA_KV_HEADS, HEAD_DIM)
    return q, k, v


def swa_attend(q, k, v, key_valid, bias, sinks):
    s = jnp.einsum('bnqhgd,bnshd->bnhgqs', q, k).astype(jnp.float32) * ATTN_SCALE
    s = s + bias.reshape(SWA_KV_HEADS, SWA_GROUP, *bias.shape[1:])
    s = jnp.where(key_valid[None, :, None, None, None, :], s, -jnp.inf)
    sink = sinks.astype(jnp.float32).reshape(SWA_KV_HEADS, SWA_GROUP)[:, :, None, None]
    m = jnp.maximum(jnp.max(s, axis=-1, keepdims=True), sink)
    p = jnp.exp(s - m)
    denom = jnp.sum(p, axis=-1, keepdims=True) + jnp.exp(sink - m)
    return jnp.einsum('bnhgqs,bnshd->bnqhgd', (p / denom).astype(v.dtype), v)


def swa_prompt(x, w_qkv, sinks, w_out, table):
    B, T, _ = x.shape
    nc = T // CHUNK
    hist = WIN_CHUNKS * CHUNK
    q, k, v = swa_project(x, w_qkv)
    q = q.reshape(B, nc, CHUNK, SWA_KV_HEADS, SWA_GROUP, HEAD_DIM)

    def band(t):
        tp = jnp.pad(t, ((0, 0), (hist, 0), (0, 0), (0, 0))).reshape(B, nc + WIN_CHUNKS, CHUNK, SWA_KV_HEADS, HEAD_DIM)
        return jnp.concatenate([tp[:, c:c + nc] for c in range(WIN_CHUNKS + 1)], axis=2)

    n_keys = (WIN_CHUNKS + 1) * CHUNK
    key_pos = jnp.arange(nc)[:, None] * CHUNK - hist + jnp.arange(n_keys)[None, :]
    rel = jnp.arange(n_keys)[None, :] - hist - jnp.arange(CHUNK)[:, None]
    o = swa_attend(q, band(k), band(v), key_pos >= 0, t5_relative_bias(rel, table), sinks)
    y = o.reshape(B, T, N_HEADS * HEAD_DIM) @ w_out
    return y, k[:, -WINDOW:], v[:, -WINDOW:]


def swa_sample(x, k_cache, v_cache, w_qkv, sinks, w_out, table):
    B, T, _ = x.shape
    hist = k_cache.shape[1]
    q, k, v = swa_project(x, w_qkv)
    k_all = jnp.concatenate([k_cache.astype(k.dtype), k], axis=1)
    v_all = jnp.concatenate([v_cache.astype(v.dtype), v], axis=1)
    rel = jnp.arange(hist + T)[None, :] - hist - jnp.arange(T)[:, None]
    valid = jnp.ones((1, hist + T), dtype=bool)
    o = swa_attend(q[:, None], k_all[:, None], v_all[:, None], valid, t5_relative_bias(rel, table), sinks)
    y = o.reshape(B, T, N_HEADS * HEAD_DIM) @ w_out
    return y, k_all[:, -hist:], v_all[:, -hist:]


def fox_project(x, w_in, b_f):
    B, T, _ = x.shape
    hd = N_HEADS * HEAD_DIM
    proj = x @ w_in
    q = proj[..., :hd].reshape(B, T, N_HEADS, HEAD_DIM)
    k = proj[..., hd:2 * hd].reshape(B, T, N_HEADS, HEAD_DIM)
    v = proj[..., 2 * hd:3 * hd].reshape(B, T, N_HEADS, HEAD_DIM)
    logf = jax.nn.log_sigmoid(proj[..., 3 * hd:].astype(jnp.float32) + b_f.astype(jnp.float32))
    return q, k, v, logf


def fox_attend(q, cq, qpos, k, v, ck, kpos):
    s = jnp.einsum('bqhd,bshd->bhqs', q, k).astype(jnp.float32) * ATTN_SCALE
    s = s + jnp.swapaxes(cq, 1, 2)[..., :, None] - jnp.swapaxes(ck, 1, 2)[..., None, :]
    s = jnp.where(kpos[None, :] <= qpos[:, None], s, -jnp.inf)
    p = jax.nn.softmax(s, axis=-1)
    return jnp.einsum('bhqs,bshd->bqhd', p.astype(v.dtype), v)


def fox_prompt(x, w_in, b_f, w_out):
    B, T, _ = x.shape
    q, k, v, logf = fox_project(x, w_in, b_f)
    c = jnp.cumsum(logf, axis=1)
    nqb = T // FOX_Q_BLOCK
    pos = jnp.arange(T)
    qb = q.reshape(B, nqb, FOX_Q_BLOCK, N_HEADS, HEAD_DIM).swapaxes(0, 1)
    cqb = c.reshape(B, nqb, FOX_Q_BLOCK, N_HEADS).swapaxes(0, 1)
    pb = pos.reshape(nqb, FOX_Q_BLOCK)
    o = lax.map(lambda blk: fox_attend(blk[0], blk[1], blk[2], k, v, c, pos), (qb, cqb, pb))
    o = o.swapaxes(0, 1).reshape(B, T, N_HEADS * HEAD_DIM)
    return o @ w_out, k, v, logf.astype(x.dtype)


def fox_sample(x, k_cache, v_cache, logf_cache, w_in, b_f, w_out):
    B, T, _ = x.shape
    L = k_cache.shape[1]
    q, k, v, logf = fox_project(x, w_in, b_f)
    k_all = jnp.concatenate([k_cache.astype(k.dtype), k], axis=1)
    v_all = jnp.concatenate([v_cache.astype(v.dtype), v], axis=1)
    c = jnp.cumsum(jnp.concatenate([logf_cache.astype(jnp.float32), logf], axis=1), axis=1)
    pos = jnp.arange(L + T)
    o = fox_attend(q, c[:, L:], pos[L:], k_all, v_all, c, pos)
    return o.reshape(B, T, N_HEADS * HEAD_DIM) @ w_out, k, v, logf.astype(x.dtype)


def setup_inputs(seed: int = 0) -> dict:
    key = jax.random.key(seed)
    ks = jax.random.split(key, 32)

    def nrm(i, shape, scale=1.0):
        return scale * jax.random.normal(ks[i], shape, jnp.float32)

    hd = N_HEADS * HEAD_DIM
    kvd = SWA_KV_HEADS * HEAD_DIM
    swa_rows = min(WINDOW, PAST_LEN)
    lam_u = jax.random.uniform(ks[18], (N_RG, LRU_WIDTH), jnp.float32, 0.9, 0.999)
    lam_s = lam_u ** (1.0 / LRU_C)
    return {
        "x_prompt": nrm(0, (BATCH, SEQ, D_MODEL)),
        "x_sample": nrm(1, (DEC_BATCH, DEC_SEQ, D_MODEL)),
        "state_rg_conv": nrm(2, (N_RG, DEC_BATCH, CONV_WIDTH - 1, LRU_WIDTH)),
        "state_rg_h": nrm(3, (N_RG, DEC_BATCH, LRU_WIDTH), 0.5),
        "cache_swa_k": nrm(4, (N_SWA, DEC_BATCH, swa_rows, SWA_KV_HEADS, HEAD_DIM)),
        "cache_swa_v": nrm(5, (N_SWA, DEC_BATCH, swa_rows, SWA_KV_HEADS, HEAD_DIM), BETA),
        "cache_fox_k": nrm(6, (N_FOX, DEC_BATCH, PAST_LEN, N_HEADS, HEAD_DIM)),
        "cache_fox_v": nrm(7, (N_FOX, DEC_BATCH, PAST_LEN, N_HEADS, HEAD_DIM), BETA),
        "cache_fox_logf": jax.nn.log_sigmoid(2.5 + nrm(8, (N_FOX, DEC_BATCH, PAST_LEN, N_HEADS))),
        "ln_gain": 1.0 + nrm(9, (DEPTH, 2, D_MODEL), 0.01),
        "ln_bias": nrm(10, (DEPTH, 2, D_MODEL), 0.01),
        "ffn_w_up": nrm(11, (DEPTH, D_MODEL, D_FF), D_MODEL ** -0.5),
        "ffn_w_down": nrm(12, (DEPTH, D_FF, D_MODEL), BETA * D_FF ** -0.5),
        "rg_w_in": nrm(13, (N_RG, D_MODEL, 2 * LRU_WIDTH), D_MODEL ** -0.5),
        "rg_conv_w": nrm(14, (N_RG, CONV_WIDTH, LRU_WIDTH), CONV_WIDTH ** -0.5),
        "rg_conv_b": nrm(15, (N_RG, LRU_WIDTH), 0.01),
        "rg_gate_w": nrm(16, (N_RG, LRU_BLOCKS, LRU_BLOCK_W, 2 * LRU_BLOCK_W), LRU_BLOCK_W ** -0.5),
        "rg_gate_b": nrm(17, (N_RG, LRU_BLOCKS, 2 * LRU_BLOCK_W), 0.01),
        "rg_lambda": jnp.log(lam_s) - jnp.log1p(-lam_s),
        "rg_w_out": nrm(19, (N_RG, LRU_WIDTH, D_MODEL), BETA * LRU_WIDTH ** -0.5),
        "swa_w_qkv": jnp.concatenate([nrm(20, (N_SWA, D_MODEL, hd), D_MODEL ** -0.5),
                                      nrm(21, (N_SWA, D_MODEL, kvd), D_MODEL ** -0.5),
                                      nrm(22, (N_SWA, D_MODEL, kvd), BETA * D_MODEL ** -0.5)], axis=-1),
        "swa_sinks": nrm(23, (N_SWA, N_HEADS), 0.5),
        "swa_w_out": nrm(24, (N_SWA, hd, D_MODEL), BETA * hd ** -0.5),
        "rel_bias_table": nrm(25, (N_BUCKETS, N_HEADS), 0.5),
        "fox_w_in": jnp.concatenate([nrm(26, (N_FOX, D_MODEL, 2 * hd), D_MODEL ** -0.5),
                                     nrm(27, (N_FOX, D_MODEL, hd), BETA * D_MODEL ** -0.5),
                                     nrm(28, (N_FOX, D_MODEL, N_HEADS), 0.5 * D_MODEL ** -0.5)], axis=-1),
        "fox_b_f": jax.random.uniform(ks[29], (N_FOX, N_HEADS), jnp.float32, 1.0, 4.0),
        "fox_w_out": nrm(30, (N_FOX, hd, D_MODEL), BETA * hd ** -0.5),
    }


def reference(x_prompt, x_sample, state_rg_conv, state_rg_h, cache_swa_k, cache_swa_v,
              cache_fox_k, cache_fox_v, cache_fox_logf, ln_gain, ln_bias, ffn_w_up, ffn_w_down,
              rg_w_in, rg_conv_w, rg_conv_b, rg_gate_w, rg_gate_b, rg_lambda, rg_w_out,
              swa_w_qkv, swa_sinks, swa_w_out, rel_bias_table, fox_w_in, fox_b_f, fox_w_out):
    xp, xs = x_prompt, x_sample
    B = xp.shape[0]
    rg_conv_p, rg_conv_s, rg_h_p, rg_h_s = [], [], [], []
    swa_k_p, swa_k_s, swa_v_p, swa_v_s = [], [], [], []
    fox_k_p, fox_k_s, fox_v_p, fox_v_s, fox_f_p, fox_f_s = [], [], [], [], [], []
    for i in range(DEPTH):
        kind, j = i % N_MIXERS, i // N_MIXERS
        if kind == 0:
            w = (rg_w_in[j], rg_conv_w[j], rg_conv_b[j], rg_gate_w[j], rg_gate_b[j], rg_lambda[j], rg_w_out[j])
            mp, cb_p, h_p = rglru_mixer(xp, jnp.zeros((B, CONV_WIDTH - 1, LRU_WIDTH), xp.dtype),
                                        jnp.zeros((B, LRU_WIDTH), xp.dtype), *w)
            ms, cb_s, h_s = rglru_mixer(xs, state_rg_conv[j], state_rg_h[j], *w)
            rg_conv_p.append(cb_p); rg_conv_s.append(cb_s); rg_h_p.append(h_p); rg_h_s.append(h_s)
        elif kind == 1:
            mp, kp, vp = swa_prompt(xp, swa_w_qkv[j], swa_sinks[j], swa_w_out[j], rel_bias_table)
            ms, kk, vv = swa_sample(xs, cache_swa_k[j], cache_swa_v[j], swa_w_qkv[j], swa_sinks[j],
                                    swa_w_out[j], rel_bias_table)
            swa_k_p.append(kp); swa_v_p.append(vp); swa_k_s.append(kk); swa_v_s.append(vv)
        else:
            mp, kp, vp, fp = fox_prompt(xp, fox_w_in[j], fox_b_f[j], fox_w_out[j])
            ms, kk, vv, fs = fox_sample(xs, cache_fox_k[j], cache_fox_v[j], cache_fox_logf[j],
                                        fox_w_in[j], fox_b_f[j], fox_w_out[j])
            fox_k_p.append(kp); fox_v_p.append(vp); fox_f_p.append(fp)
            fox_k_s.append(kk); fox_v_s.append(vv); fox_f_s.append(fs)
        xp = layer_norm(ALPHA * xp + mp, ln_gain[i, 0], ln_bias[i, 0])
        xs = layer_norm(ALPHA * xs + ms, ln_gain[i, 0], ln_bias[i, 0])
        xp = layer_norm(ALPHA * xp + sq_relu_mlp(xp, ffn_w_up[i], ffn_w_down[i]), ln_gain[i, 1], ln_bias[i, 1])
        xs = layer_norm(ALPHA * xs + sq_relu_mlp(xs, ffn_w_up[i], ffn_w_down[i]), ln_gain[i, 1], ln_bias[i, 1])
    return (xp, xs,
            jnp.stack(rg_conv_p), jnp.stack(rg_conv_s), jnp.stack(rg_h_p), jnp.stack(rg_h_s),
            jnp.stack(swa_k_p), jnp.stack(swa_k_s), jnp.stack(swa_v_p), jnp.stack(swa_v_s),
            jnp.stack(fox_k_p), jnp.stack(fox_k_s), jnp.stack(fox_v_p), jnp.stack(fox_v_s),
            jnp.stack(fox_f_p), jnp.stack(fox_f_s))
```

```cpp
#include <hip/hip_runtime.h>
#include <cstdio>
#include <cstdint>
#include <cmath>

#ifndef MK_PER_PHASE
#define MK_PER_PHASE 0
#endif

#ifndef ENMASK
#define ENMASK 0xFFFFFFFFu
#endif
#define EN(id) (((ENMASK) >> (id)) & 1u)
#define LAS __attribute__((address_space(3)))
#define GAS __attribute__((address_space(1)))
typedef unsigned short bf16_t;
typedef short bf16x8 __attribute__((ext_vector_type(8)));
typedef short s16x4 __attribute__((ext_vector_type(4)));
typedef float f32x4 __attribute__((ext_vector_type(4)));
typedef float f32x2 __attribute__((ext_vector_type(2)));
typedef float f32x16 __attribute__((ext_vector_type(16)));
typedef unsigned u32x4 __attribute__((ext_vector_type(4)));
typedef unsigned u32x2 __attribute__((ext_vector_type(2)));
typedef __bf16 bf16x2_t __attribute__((ext_vector_type(2)));

constexpr int D = 1024, FF = 4096, NH = 16, HD = 64, KVH = 4;
constexpr int BP = 4, TP = 4096, BS = 16, TS = 64, PAST = 1024, WIN = 128;
constexpr int MP = BP * TP, MS = BS * TS, M = MP + MS;
constexpr int DEPTH = 4;
constexpr float ALPHA = 1.6817928305074290f;
constexpr float LN_EPS = 1e-5f;
constexpr float LOG2E = 1.4426950408889634f;
constexpr float C2 = 0.125f * LOG2E;
constexpr int KSW_ROWS = MP + BS * 192;
constexpr int KFX_ROWS = MP + BS * 1088;

constexpr size_t O_Y = 0;
constexpr size_t O_RGCONV_P = (size_t)M * D;
constexpr size_t O_RGCONV_S = O_RGCONV_P + 2 * BP * 3 * D;
constexpr size_t O_RGH_P = O_RGCONV_S + 2 * BS * 3 * D;
constexpr size_t O_RGH_S = O_RGH_P + 2 * BP * D;
constexpr size_t O_SWAK_P = O_RGH_S + 2 * BS * D;
constexpr size_t O_SWAK_S = O_SWAK_P + (size_t)BP * WIN * 256;
constexpr size_t O_SWAV_P = O_SWAK_S + (size_t)BS * WIN * 256;
constexpr size_t O_SWAV_S = O_SWAV_P + (size_t)BP * WIN * 256;
constexpr size_t O_FOXK = O_SWAV_S + (size_t)BS * WIN * 256;
constexpr size_t O_FOXV = O_FOXK + (size_t)M * D;
constexpr size_t O_FOXF = O_FOXV + (size_t)M * D;
constexpr size_t O_END = O_FOXF + (size_t)M * NH;
static_assert(O_END == 55230464, "output size");

constexpr size_t MiB = 1u << 20;
constexpr size_t WS_CTL = 0, CTL_ZERO_BYTES = 1 * MiB;
constexpr size_t WS_WUP = 2 * MiB, WS_WDOWN = 34 * MiB, WS_WRGIN = 66 * MiB, WS_WRGGATE = 74 * MiB, WS_WRGOUT = 76 * MiB;
constexpr size_t WS_WSWAQKV = 80 * MiB, WS_WSWAOUT = 83 * MiB, WS_WFOXIN = 85 * MiB, WS_WFOXOUT = 91 * MiB;
constexpr size_t WS_XN = 94 * MiB;
constexpr size_t WS_CHA = 128 * MiB, WS_CHB = 130 * MiB;
constexpr size_t WS_LOGF = 132 * MiB, WS_SP8 = 133 * MiB + 512 * 1024;
constexpr size_t WS_CK2P = 134 * MiB, WS_CK2S = 136 * MiB;
constexpr size_t WS_KSW = 138 * MiB, WS_VSW = 148 * MiB;
constexpr size_t WS_BIG = 160 * MiB;
constexpr size_t WS_H = WS_BIG;
constexpr size_t WS_G = WS_BIG, WS_U = WS_BIG + 34 * MiB, WS_CONV = WS_BIG + 102 * MiB, WS_B = WS_BIG + 136 * MiB;
constexpr size_t WS_Q = WS_BIG, WS_KF = WS_BIG + 34 * MiB, WS_VF = WS_BIG + 100 * MiB;
constexpr size_t WS_END = WS_BIG + 204 * MiB;
static_assert((size_t)KSW_ROWS * 256 * 2 <= 10 * MiB && (size_t)KFX_ROWS * 1024 * 2 <= 66 * MiB, "kv buffers");

constexpr int CW_BAR = 4096;

namespace pg8 {
constexpr int BM = 256, BK = 64, HALF = 128, HTB = HALF * BK * 2, STAGE_BYTES = 8 * HTB, NXCD = 8, WGM = 8;
__host__ __device__ __forceinline__ int lds_byte(int r, int c) { const int st = (r >> 4) * 2 + (c >> 5), rr = r & 15, cc = c & 31, ob = rr * 64 + cc * 2; return st * 1024 + (ob ^ (((ob >> 9) & 1) << 5)); }
__host__ __device__ __forceinline__ void stage_rc(int b, int& R, int& C) { const int st = b / 1024, sb = b % 1024, swz = sb ^ (((sb >> 9) & 1) << 5); R = (st >> 1) * 16 + swz / 64; C = (st & 1) * 32 + (swz % 64) / 2; }
__host__ __device__ __forceinline__ int perm32(int rho) { const int n = rho >> 4, i = rho & 15; return 8 * (i >> 2) + 4 * n + (i & 3); }

struct Unit { int pm, pn; };
struct Gemm { const bf16_t* A; const bf16_t* Bt; int M, N, K, lda, a_div, a_stride; };

struct StaticOrder {
    int nM, nN, nwg, G, c;
    __host__ __device__ void init(int M_, int N_, int G_, int c_) { nM = M_ / BM; nN = N_ / BM; nwg = nM * nN; G = G_; c = c_; }
    __host__ __device__ bool next(int i, Unit& u) const {
        const long L = (long)i * G + c; if (L >= nwg) return false;
        int wgid = (int)L; { const int q = nwg / NXCD, r = nwg % NXCD, xcd = wgid % NXCD, off = wgid / NXCD; wgid = (xcd < r ? xcd * (q + 1) : r * (q + 1) + (xcd - r) * q) + off; }
        const int nig = WGM * nN, gid = wgid / nig, fm = gid * WGM, gsz = (nM - fm) < WGM ? (nM - fm) : WGM;
        u.pm = fm + ((wgid % nig) % gsz); u.pn = (wgid % nig) / gsz; return true;
    }
};

__device__ __forceinline__ unsigned cvt_pk_bf16(float lo, float hi) { f32x2 v = {lo, hi}; bf16x2_t b = __builtin_convertvector(v, bf16x2_t); return __builtin_bit_cast(unsigned, b); }

template <class Epi, bool ALIGN_EPI>
__device__ __forceinline__ void gemm_phase(LAS unsigned char* lds, const Gemm g, const StaticOrder& S, const Epi& E) {
    int tid = threadIdx.x; asm volatile("" : "+v"(tid));
    const int wid = __builtin_amdgcn_readfirstlane(tid >> 6), lane = tid & 63, wr = wid >> 2, wc = wid & 3, fr = lane & 15, fq = lane >> 4;
    int K = g.K; asm volatile("" : "+s"(K));
    const int nt = K / BK, lda = g.lda;
    unsigned voffA[2], voffB[2];
#pragma unroll
    for (int i = 0; i < 2; ++i) { int R, C; stage_rc(tid * 16 + i * 8192, R, C); const int Rb = Epi::PERM ? ((R & ~31) + perm32(R & 31)) : R;
        voffA[i] = (unsigned)(R * lda + C) * 2u; voffB[i] = (unsigned)(Rb * K + C) * 2u; }
    const size_t kstep = (size_t)(BK * 2);
    const size_t hstepA = (size_t)HALF * lda * 2, tstepA = 2 * hstepA;
    const size_t hstepB = (size_t)HALF * K * 2, tstepB = 2 * hstepB;
    const unsigned ldsw = (unsigned)wid * 1024u;
    const int aoff = lds_byte(wr * 64 + fr, fq * 8), boff = lds_byte(wc * 32 + fr, fq * 8);
#define PG8_SA(b, h) (((b) * 2 + (h)) * HTB)
#define PG8_SB(b, h) ((4 + (b) * 2 + (h)) * HTB)
#define PG8_STAGE(bufoff, gbase, voff) do { const char* _gb = (const char*)(gbase); asm volatile("" : "+s"(_gb)); _Pragma("unroll") for (int _i = 0; _i < 2; ++_i) \
        __builtin_amdgcn_global_load_lds((const unsigned*)(_gb + (voff)[_i]), (LAS unsigned*)(lds + (bufoff) + ldsw + _i * 8192), 16, 0, 0); } while (0)
#define PG8_LDA(dst, b, h) do { _Pragma("unroll") for (int m = 0; m < 4; ++m) _Pragma("unroll") for (int k = 0; k < 2; ++k) dst[m][k] = *(const LAS bf16x8*)(lds + PG8_SA(b, h) + aoff + m * 2048 + k * 1024); } while (0)
#define PG8_LDB(dst, b, h) do { _Pragma("unroll") for (int n = 0; n < 2; ++n) _Pragma("unroll") for (int k = 0; k < 2; ++k) dst[n][k] = *(const LAS bf16x8*)(lds + PG8_SB(b, h) + boff + n * 2048 + k * 1024); } while (0)
#define PG8_MMA(ai, bj, At, Bt) do { __builtin_amdgcn_s_setprio(1); _Pragma("unroll") for (int m = 0; m < 4; ++m) _Pragma("unroll") for (int n = 0; n < 2; ++n) _Pragma("unroll") for (int k = 0; k < 2; ++k) \
        acc[ai][bj][m][n] = __builtin_amdgcn_mfma_f32_16x16x32_bf16(Bt[n][k], At[m][k], acc[ai][bj][m][n], 0, 0, 0); __builtin_amdgcn_s_setprio(0); } while (0)
#define PG8_WAIT_V(n) asm volatile("s_waitcnt vmcnt(" #n ")" ::: "memory")
#define PG8_WAIT_L(n) asm volatile("s_waitcnt lgkmcnt(" #n ")" ::: "memory")
#define PG8_BAR __builtin_amdgcn_s_barrier()
#define PG8_SCHED __builtin_amdgcn_sched_barrier(0)
#define PG8_APTR(u) ((const char*)g.A + (size_t)(u).pm * tstepA + (size_t)(((u).pn / g.a_div) * g.a_stride) * 2)
#define PG8_BPTR(u) ((const char*)g.Bt + (size_t)(u).pn * tstepB)
    Unit cur, nxt; int ui = 0;
    if (!S.next(0, cur)) return;
    f32x4 acc[2][2][4][2];
#pragma unroll
    for (int a = 0; a < 2; ++a)
#pragma unroll
        for (int b = 0; b < 2; ++b)
#pragma unroll
            for (int m = 0; m < 4; ++m)
#pragma unroll
                for (int n = 0; n < 2; ++n) acc[a][b][m][n] = (f32x4){0.f, 0.f, 0.f, 0.f};
    bf16x8 At[4][2], B0[2][2], B1[2][2];
    const char* cA = PG8_APTR(cur); const char* cB = PG8_BPTR(cur);
    PG8_STAGE(PG8_SB(0, 0), cB, voffB); PG8_STAGE(PG8_SB(0, 1), cB + hstepB, voffB); PG8_STAGE(PG8_SA(0, 0), cA, voffA); PG8_STAGE(PG8_SA(0, 1), cA + hstepA, voffA);
    if (wr == 1) PG8_BAR;
    PG8_WAIT_V(2); PG8_BAR;
    PG8_STAGE(PG8_SB(1, 0), cB + kstep, voffB); PG8_STAGE(PG8_SA(1, 0), cA + kstep, voffA); PG8_STAGE(PG8_SB(1, 1), cB + hstepB + kstep, voffB);
    PG8_WAIT_V(6); PG8_BAR;
    for (;;) {
        const bool has_next = S.next(ui + 1, nxt);
        const char* nA = has_next ? PG8_APTR(nxt) : cA; const char* nB = has_next ? PG8_BPTR(nxt) : cB;
        for (int t = 0; t < nt; t += 2) {
            const bool last = (t == nt - 2);
            const char* a1 = cA + (size_t)(t + 1) * kstep;
            const char* a2 = last ? nA : cA + (size_t)(t + 2) * kstep; const char* b2 = last ? nB : cB + (size_t)(t + 2) * kstep;
            const char* a3 = a2 + kstep; const char* b3 = b2 + kstep;
            PG8_LDB(B0, 0, 0); PG8_LDB(B1, 0, 1); PG8_SCHED; PG8_LDA(At, 0, 0); PG8_STAGE(PG8_SA(1, 1), a1 + hstepA, voffA);
            PG8_WAIT_V(8); PG8_WAIT_L(0); PG8_BAR; PG8_MMA(0, 0, At, B0); PG8_MMA(0, 1, At, B1); PG8_BAR; PG8_SCHED;
            PG8_LDA(At, 0, 1); PG8_STAGE(PG8_SB(0, 0), b2, voffB); PG8_STAGE(PG8_SB(0, 1), b2 + hstepB, voffB); PG8_STAGE(PG8_SA(0, 0), a2, voffA);
            PG8_WAIT_V(8); PG8_WAIT_L(0); PG8_BAR; PG8_MMA(1, 0, At, B0); PG8_MMA(1, 1, At, B1); PG8_BAR; PG8_SCHED;
            PG8_LDB(B0, 1, 0); PG8_LDB(B1, 1, 1); PG8_SCHED; PG8_LDA(At, 1, 0); PG8_STAGE(PG8_SA(0, 1), a2 + hstepA, voffA);
            PG8_WAIT_V(8); PG8_WAIT_L(0); PG8_BAR; PG8_MMA(0, 0, At, B0); PG8_MMA(0, 1, At, B1); PG8_BAR; PG8_SCHED;
            PG8_LDA(At, 1, 1); PG8_STAGE(PG8_SB(1, 0), b3, voffB); PG8_STAGE(PG8_SB(1, 1), b3 + hstepB, voffB); PG8_STAGE(PG8_SA(1, 0), a3, voffA);
            PG8_WAIT_V(8); PG8_WAIT_L(0); PG8_BAR; PG8_MMA(1, 0, At, B0); PG8_MMA(1, 1, At, B1); PG8_BAR; PG8_SCHED;
        }
        if constexpr (ALIGN_EPI) { if (wr == 0) PG8_BAR; }
        E(acc, cur, wr, wc, fr, fq);
        if (!has_next) break;
#pragma unroll
        for (int a = 0; a < 2; ++a)
#pragma unroll
            for (int b = 0; b < 2; ++b)
#pragma unroll
                for (int m = 0; m < 4; ++m)
#pragma unroll
                    for (int n = 0; n < 2; ++n) acc[a][b][m][n] = (f32x4){0.f, 0.f, 0.f, 0.f};
        cur = nxt; cA = nA; cB = nB; ++ui;
        if constexpr (ALIGN_EPI) { if (wr == 1) PG8_BAR; }
    }
    PG8_WAIT_V(0);
    if constexpr (!ALIGN_EPI) { if (wr == 0) PG8_BAR; }
    PG8_BAR;
#undef PG8_SA
#undef PG8_SB
#undef PG8_STAGE
#undef PG8_LDA
#undef PG8_LDB
#undef PG8_MMA
#undef PG8_WAIT_V
#undef PG8_WAIT_L
#undef PG8_BAR
#undef PG8_SCHED
#undef PG8_APTR
#undef PG8_BPTR
}

__device__ __forceinline__ float gelu_tanh(float x) {
    const float z = x * (1.0f + 0.044715f * x * x);
    const float e = __builtin_amdgcn_exp2f(z * (-2.0f * 0.7978845608028654f * LOG2E));
    return x * __builtin_amdgcn_rcpf(1.0f + e);
}
__device__ __forceinline__ u32x4 pack8(const f32x4 v0, const f32x4 v1) { u32x4 w; w.x = cvt_pk_bf16(v0[0], v0[1]); w.y = cvt_pk_bf16(v0[2], v0[3]); w.z = cvt_pk_bf16(v1[0], v1[1]); w.w = cvt_pk_bf16(v1[2], v1[3]); return w; }

struct EpiRgIn {
    static constexpr bool PERM = true;
    bf16_t* G; float* U;
    __device__ __forceinline__ void operator()(const f32x4 (&acc)[2][2][4][2], const Unit& u, int wr, int wc, int fr, int fq) const {
        asm volatile("" : "+v"(fr), "+v"(fq));
        const int row0 = u.pm * BM + wr * 64 + fr; const int colt = u.pn * BM; const bool isU = colt >= D;
        const int col0 = (colt & (D - 1)) + wc * 32 + 8 * fq;
#pragma unroll
        for (int ai = 0; ai < 2; ++ai)
#pragma unroll
            for (int m = 0; m < 4; ++m) { const size_t ro = (size_t)(row0 + ai * HALF + m * 16) * D + col0;
#pragma unroll
                for (int bj = 0; bj < 2; ++bj) { const f32x4 v0 = acc[ai][bj][m][0], v1 = acc[ai][bj][m][1];
                    if (isU) { *(f32x4*)(U + ro + bj * HALF) = v0; *(f32x4*)(U + ro + bj * HALF + 4) = v1; }
                    else { f32x4 g0, g1;
#pragma unroll
                        for (int e = 0; e < 4; ++e) { g0[e] = gelu_tanh(v0[e]); g1[e] = gelu_tanh(v1[e]); }
                        *(u32x4*)(G + ro + bj * HALF) = pack8(g0, g1); } }
                asm volatile("" ::: "memory"); }
    }
};
struct EpiGates {
    static constexpr bool PERM = false;
    const float* gate_b; const float* sp8; const bf16_t* CONV; float* Aout; float* Bout;
    __device__ __forceinline__ void operator()(const f32x4 (&acc)[2][2][4][2], const Unit& u, int wr, int wc, int fr, int fq) const {
        asm volatile("" : "+v"(fr), "+v"(fq));
        const int nb = u.pn >> 1, pn2 = u.pn & 1; const int row0 = u.pm * BM + wr * 64 + fr;
#pragma unroll
        for (int n = 0; n < 2; ++n) { const int c = pn2 * 128 + wc * 32 + 16 * n + 4 * fq; const int ch = nb * 256 + c;
            const f32x4 gbr = *(const f32x4*)(gate_b + nb * 512 + c), gbi = *(const f32x4*)(gate_b + nb * 512 + 256 + c), s8 = *(const f32x4*)(sp8 + ch);
#pragma unroll
            for (int ai = 0; ai < 2; ++ai)
#pragma unroll
                for (int m = 0; m < 4; ++m) { const size_t ro = (size_t)(row0 + ai * HALF + m * 16) * D + ch;
                    const f32x4 rp = acc[ai][0][m][n] + gbr, ip = acc[ai][1][m][n] + gbi;
                    const u32x2 cw = *(const u32x2*)(CONV + ro);
                    float cv[4]; cv[0] = __uint_as_float(cw.x << 16); cv[1] = __uint_as_float(cw.x & 0xffff0000u); cv[2] = __uint_as_float(cw.y << 16); cv[3] = __uint_as_float(cw.y & 0xffff0000u);
                    f32x4 av, bv;
#pragma unroll
                    for (int e = 0; e < 4; ++e) {
                        const float r = __builtin_amdgcn_rcpf(1.0f + __builtin_amdgcn_exp2f(-LOG2E * rp[e])), ig = __builtin_amdgcn_rcpf(1.0f + __builtin_amdgcn_exp2f(-LOG2E * ip[e]));
                        const float la = -r * s8[e]; av[e] = __builtin_amdgcn_exp2f(LOG2E * la);
                        const float y = 2.0f * la;
                        const float ser = -y * (1.0f + y * (0.5f + y * (0.16666667f + y * 0.041666668f)));
                        const float dir = 1.0f - __builtin_amdgcn_exp2f(LOG2E * y);
                        const float om = (y > -0.0625f) ? ser : dir;
                        bv[e] = __builtin_sqrtf(om) * (ig * cv[e]); }
                    *(f32x4*)(Aout + ro) = av; *(f32x4*)(Bout + ro) = bv;
                    asm volatile("" ::: "memory"); } }
    }
};
struct EpiResid {
    static constexpr bool PERM = false;
    float* X;
    __device__ __forceinline__ void operator()(const f32x4 (&acc)[2][2][4][2], const Unit& u, int wr, int wc, int fr, int fq) const {
        asm volatile("" : "+v"(fr), "+v"(fq));
        const int row0 = u.pm * BM + wr * 64 + fr, col0 = u.pn * BM + wc * 32 + 4 * fq;
#pragma unroll
        for (int ai = 0; ai < 2; ++ai)
#pragma unroll
            for (int m = 0; m < 4; ++m) { float* xr = X + (size_t)(row0 + ai * HALF + m * 16) * D + col0;
#pragma unroll
                for (int bj = 0; bj < 2; ++bj)
#pragma unroll
                    for (int n = 0; n < 2; ++n) { f32x4* p = (f32x4*)(xr + bj * HALF + n * 16); const f32x4 x = *p; *p = x * ALPHA + acc[ai][bj][m][n]; }
                if (m & 1) asm volatile("" ::: "memory"); }
    }
};
struct EpiSqRelu {
    static constexpr bool PERM = true;
    bf16_t* Hb;
    __device__ __forceinline__ void operator()(const f32x4 (&acc)[2][2][4][2], const Unit& u, int wr, int wc, int fr, int fq) const {
        asm volatile("" : "+v"(fr), "+v"(fq));
        const int row0 = u.pm * BM + wr * 64 + fr, col0 = u.pn * BM + wc * 32 + 8 * fq;
#pragma unroll
        for (int ai = 0; ai < 2; ++ai)
#pragma unroll
            for (int m = 0; m < 4; ++m) { bf16_t* hr = Hb + (size_t)(row0 + ai * HALF + m * 16) * FF + col0;
#pragma unroll
                for (int bj = 0; bj < 2; ++bj) { f32x4 v0 = acc[ai][bj][m][0], v1 = acc[ai][bj][m][1];
#pragma unroll
                    for (int e = 0; e < 4; ++e) { const float a = fmaxf(v0[e], 0.f), b = fmaxf(v1[e], 0.f); v0[e] = a * a; v1[e] = b * b; }
                    *(u32x4*)(hr + bj * HALF) = pack8(v0, v1); }
                asm volatile("" ::: "memory"); }
    }
};
struct EpiSwaQkv {
    static constexpr bool PERM = true;
    bf16_t* Q; bf16_t* Kb; bf16_t* Vb; float* outKp; float* outKs; float* outVp; float* outVs;
    __device__ __forceinline__ void operator()(const f32x4 (&acc)[2][2][4][2], const Unit& u, int wr, int wc, int fr, int fq) const {
        asm volatile("" : "+v"(fr), "+v"(fq));
        const int row0 = u.pm * BM + wr * 64 + fr; const int cl = wc * 32 + 8 * fq;
        if (u.pn < 4) {
#pragma unroll
            for (int ai = 0; ai < 2; ++ai)
#pragma unroll
                for (int m = 0; m < 4; ++m) { bf16_t* qr = Q + (size_t)(row0 + ai * HALF + m * 16) * D + u.pn * BM + cl;
#pragma unroll
                    for (int bj = 0; bj < 2; ++bj) *(u32x4*)(qr + bj * HALF) = pack8(acc[ai][bj][m][0] * C2, acc[ai][bj][m][1] * C2);
                    asm volatile("" ::: "memory"); }
        } else {
            bf16_t* KV = (u.pn == 4) ? Kb : Vb; float* op = (u.pn == 4) ? outKp : outVp; float* os = (u.pn == 4) ? outKs : outVs;
#pragma unroll
            for (int ai = 0; ai < 2; ++ai)
#pragma unroll
                for (int m = 0; m < 4; ++m) { const int row = row0 + ai * HALF + m * 16; int krow; float* fo = nullptr;
                    if (row < MP) { krow = row; const int b = row >> 12, t = row & (TP - 1); if (t >= TP - WIN) fo = op + (size_t)(b * WIN + (t - (TP - WIN))) * 256; }
                    else { const int rs = row - MP, b = rs >> 6, t = rs & 63; krow = MP + b * 192 + 128 + t; fo = os + (size_t)(b * WIN + 64 + t) * 256; }
#pragma unroll
                    for (int bj = 0; bj < 2; ++bj) { const f32x4 v0 = acc[ai][bj][m][0], v1 = acc[ai][bj][m][1];
                        *(u32x4*)(KV + (size_t)krow * 256 + cl + bj * HALF) = pack8(v0, v1);
                        if (fo) { *(f32x4*)(fo + cl + bj * HALF) = v0; *(f32x4*)(fo + cl + bj * HALF + 4) = v1; } }
                    asm volatile("" ::: "memory"); }
        }
    }
};
struct EpiFoxIn {
    static constexpr bool PERM = true;
    bf16_t* Q; bf16_t* Kb; bf16_t* Vb; float* outK; float* outV;
    __device__ __forceinline__ void operator()(const f32x4 (&acc)[2][2][4][2], const Unit& u, int wr, int wc, int fr, int fq) const {
        asm volatile("" : "+v"(fr), "+v"(fq));
        const int row0 = u.pm * BM + wr * 64 + fr; const int cl = (u.pn & 3) * BM + wc * 32 + 8 * fq;
        if (u.pn < 4) {
#pragma unroll
            for (int ai = 0; ai < 2; ++ai)
#pragma unroll
                for (int m = 0; m < 4; ++m) { bf16_t* qr = Q + (size_t)(row0 + ai * HALF + m * 16) * D + cl;
#pragma unroll
                    for (int bj = 0; bj < 2; ++bj) *(u32x4*)(qr + bj * HALF) = pack8(acc[ai][bj][m][0] * C2, acc[ai][bj][m][1] * C2);
                    asm volatile("" ::: "memory"); }
        } else {
            bf16_t* KV = (u.pn < 8) ? Kb : Vb; float* of = (u.pn < 8) ? outK : outV;
#pragma unroll
            for (int ai = 0; ai < 2; ++ai)
#pragma unroll
                for (int m = 0; m < 4; ++m) { const int row = row0 + ai * HALF + m * 16;
                    const int krow = (u.pm < MP / BM) ? row : row + (((row - MP) >> 6) + 1) * PAST;
#pragma unroll
                    for (int bj = 0; bj < 2; ++bj) { const f32x4 v0 = acc[ai][bj][m][0], v1 = acc[ai][bj][m][1];
                        *(u32x4*)(KV + (size_t)krow * D + cl + bj * HALF) = pack8(v0, v1);
                        float* fo = of + (size_t)row * D + cl + bj * HALF; *(f32x4*)fo = v0; *(f32x4*)(fo + 4) = v1; }
                    asm volatile("" ::: "memory"); }
        }
    }
};
}

namespace att {
constexpr int SLOTB = 8192, NSLOT = 3;
constexpr int L_K = 0, L_V = NSLOT * SLOTB, L_WS = 2 * NSLOT * SLOTB, L_OST = L_WS + 8 * 256, L_AUX = L_OST + 8 * 4096;
constexpr int AUX_BYTES = 17408;
static_assert(L_AUX + AUX_BYTES <= 131072, "attention LDS");
typedef LAS const char* lcp;
__device__ __forceinline__ int crow(int r, int hi) { return (r & 3) + 8 * (r >> 2) + 4 * hi; }
__device__ __forceinline__ void glds16(const void* gsrc, unsigned lds_dst) { unsigned keep;
    asm volatile("s_mov_b32 %0, m0\n\ts_mov_b32 m0, %2\n\ts_nop 0\n\tglobal_load_lds_dwordx4 %1, off\n\ts_mov_b32 m0, %0" : "=&s"(keep) : "v"(gsrc), "s"(lds_dst) : "memory"); }
#define ATT_WAIT_BAR(N) asm volatile("s_waitcnt vmcnt(" #N ") lgkmcnt(0)\n\ts_barrier" ::: "memory")
typedef short v4i16_t __attribute__((ext_vector_type(4)));
__device__ __forceinline__ s16x4 vtr(lcp p) { return __builtin_bit_cast(s16x4, __builtin_amdgcn_ds_read_tr16_b64_v4i16((LAS v4i16_t*)p)); }

template <int MODE>
__device__ __forceinline__ void attn_unit(LAS unsigned char* shm, const bf16_t* Qw, bf16_t* Ow, int qpitch, const bf16_t* Kb, const bf16_t* Vb, int kvpitch,
                                          int t0, int t1, bool active, int qpos0w  ,
                                          const float* aux_src, int aux_n, float m_init, int tbl_off  ) {
    int tid = threadIdx.x; asm volatile("" : "+v"(tid));
    const int lane = tid & 63, r32 = lane & 31, hi = lane >> 5; const int wid = __builtin_amdgcn_readfirstlane(tid >> 6);
    const unsigned lds0 = (unsigned)(uintptr_t)shm;
    LAS float* wsf = (LAS float*)(shm + L_WS) + wid * 64;
    LAS float* aux = (LAS float*)(shm + L_AUX);
    if (MODE == 0) { for (int i = tid; i < aux_n; i += 512) aux[i] = aux_src[i]; }
    const bf16_t* ksrc = Kb + (size_t)lane * kvpitch + wid * 8;
    const bf16_t* vsrc = Vb + (size_t)(16 * (wid & 3) + (lane >> 2)) * kvpitch + (wid >> 2) * 32 + (lane & 3) * 8;
    const unsigned kdst = lds0 + L_K + wid * 1024, vdst = lds0 + L_V + wid * 1024;
#define DMA_KV(t, slot) do { glds16(ksrc + (size_t)(t) * 64 * kvpitch, (unsigned)__builtin_amdgcn_readfirstlane(kdst + (slot) * SLOTB)); \
                             glds16(vsrc + (size_t)(t) * 64 * kvpitch, (unsigned)__builtin_amdgcn_readfirstlane(vdst + (slot) * SLOTB)); } while (0)
    DMA_KV(t0, 0);
    bf16x8 qr[4];
    if (active) {
#pragma unroll
        for (int d0 = 0; d0 < 4; ++d0) qr[d0] = *(const bf16x8*)(Qw + (size_t)r32 * qpitch + d0 * 16 + hi * 8);
    } else {
#pragma unroll
        for (int d0 = 0; d0 < 4; ++d0) qr[d0] = (bf16x8){0, 0, 0, 0, 0, 0, 0, 0};
    }
    float mhat = m_init, l_reg = (MODE == 1 && hi == 0) ? 1.0f : 0.0f;
    f32x16 o[2]; o[0] = (f32x16){}; o[1] = (f32x16){};
    const int qpos = qpos0w + r32;
    const lcp kp0 = (lcp)shm + L_K + hi * 1024 + r32 * 16;
    const lcp vp0 = (lcp)shm + L_V + ((lane >> 4) & 1) * 32 + (lane & 3) * 8 + (4 * hi + ((lane & 15) >> 2)) * 64;
    int slot = 0;
    for (int t = t0; t < t1; ++t) {
        const int nslot = (slot == NSLOT - 1) ? 0 : slot + 1;
        if (t + 1 < t1) { DMA_KV(t + 1, nslot); ATT_WAIT_BAR(2); } else { ATT_WAIT_BAR(0); }
        const bool need = active && (MODE == 1 || 64 * t <= qpos0w + 31);
        if (need) {
            const lcp kp = kp0 + slot * SLOTB; const lcp vp = vp0 + slot * SLOTB;
            f32x16 p0, p1;
            if (MODE == 0) {
                const LAS f32x4* cb = (const LAS f32x4*)(aux + 64 * t + 4 * hi);
#pragma unroll
                for (int g = 0; g < 4; ++g) { const f32x4 a = cb[2 * g], b = cb[2 * g + 8];
#pragma unroll
                    for (int e = 0; e < 4; ++e) { p0[4 * g + e] = -a[e]; p1[4 * g + e] = -b[e]; } }
            } else {
                const LAS float* tb = (const LAS float*)((lcp)shm + L_AUX + tbl_off) + (64 * t + 63 - qpos);
#pragma unroll
                for (int r = 0; r < 16; ++r) { p0[r] = tb[crow(r, hi)]; p1[r] = tb[crow(r, hi) + 32]; }
            }
#pragma unroll
            for (int d0 = 0; d0 < 4; ++d0) {
                const bf16x8 b0 = *(const LAS bf16x8*)(kp + d0 * 2048);
                const bf16x8 b1 = *(const LAS bf16x8*)(kp + d0 * 2048 + 512);
                p0 = __builtin_amdgcn_mfma_f32_32x32x16_bf16(b0, qr[d0], p0, 0, 0, 0);
                p1 = __builtin_amdgcn_mfma_f32_32x32x16_bf16(b1, qr[d0], p1, 0, 0, 0);
            }
            if (MODE == 0 && 64 * t + 63 > qpos0w) {
                const int kb = 64 * t + 4 * hi;
#pragma unroll
                for (int r = 0; r < 16; ++r) { const int kv = kb + (r & 3) + 8 * (r >> 2); if (kv > qpos) p0[r] = -INFINITY; if (kv + 32 > qpos) p1[r] = -INFINITY; }
            }
            float rm = fmaxf(p0[0], p1[0]);
#pragma unroll
            for (int r = 1; r < 16; ++r) rm = fmaxf(rm, fmaxf(p0[r], p1[r]));
            { auto rr = __builtin_amdgcn_permlane32_swap(__float_as_uint(rm), __float_as_uint(rm), false, false); rm = fmaxf(__uint_as_float(rr[0]), __uint_as_float(rr[1])); }
            const float mnew = fmaxf(mhat, rm);
            const float f = __builtin_amdgcn_exp2f(mhat - mnew);
            float sacc = 0.f;
#pragma unroll
            for (int r = 0; r < 16; ++r) { p0[r] = __builtin_amdgcn_exp2f(p0[r] - mnew); p1[r] = __builtin_amdgcn_exp2f(p1[r] - mnew); sacc += p0[r] + p1[r]; }
            l_reg = l_reg * f + sacc;
            if (__any(mnew > mhat)) {
                if (hi == 0) wsf[r32] = f;
#pragma unroll
                for (int d_ = 0; d_ < 2; ++d_)
#pragma unroll
                    for (int r = 0; r < 16; ++r) o[d_][r] *= wsf[crow(r, hi)];
            }
            mhat = mnew;
            bf16x8 pa[4];
            { u32x4 w;
              w = (u32x4){pg8::cvt_pk_bf16(p0[0], p0[1]), pg8::cvt_pk_bf16(p0[2], p0[3]), pg8::cvt_pk_bf16(p0[4], p0[5]), pg8::cvt_pk_bf16(p0[6], p0[7])}; pa[0] = __builtin_bit_cast(bf16x8, w);
              w = (u32x4){pg8::cvt_pk_bf16(p0[8], p0[9]), pg8::cvt_pk_bf16(p0[10], p0[11]), pg8::cvt_pk_bf16(p0[12], p0[13]), pg8::cvt_pk_bf16(p0[14], p0[15])}; pa[1] = __builtin_bit_cast(bf16x8, w);
              w = (u32x4){pg8::cvt_pk_bf16(p1[0], p1[1]), pg8::cvt_pk_bf16(p1[2], p1[3]), pg8::cvt_pk_bf16(p1[4], p1[5]), pg8::cvt_pk_bf16(p1[6], p1[7])}; pa[2] = __builtin_bit_cast(bf16x8, w);
              w = (u32x4){pg8::cvt_pk_bf16(p1[8], p1[9]), pg8::cvt_pk_bf16(p1[10], p1[11]), pg8::cvt_pk_bf16(p1[12], p1[13]), pg8::cvt_pk_bf16(p1[14], p1[15])}; pa[3] = __builtin_bit_cast(bf16x8, w); }
#pragma unroll
            for (int d0 = 0; d0 < 2; ++d0)
#pragma unroll
                for (int ks = 0; ks < 4; ++ks) {
                    const s16x4 lo = vtr(vp + d0 * 4096 + ks * 1024), hh = vtr(vp + d0 * 4096 + ks * 1024 + 512);
                    const bf16x8 vf = (bf16x8){lo[0], lo[1], lo[2], lo[3], hh[0], hh[1], hh[2], hh[3]};
                    o[d0] = __builtin_amdgcn_mfma_f32_32x32x16_bf16(pa[ks], vf, o[d0], 0, 0, 0);
                }
        }
        slot = nslot;
    }
    if (active) {
        { auto rr = __builtin_amdgcn_permlane32_swap(__float_as_uint(l_reg), __float_as_uint(l_reg), false, false); l_reg = __uint_as_float(rr[0]) + __uint_as_float(rr[1]); }
        if (hi == 0) wsf[32 + r32] = l_reg;
        float rli[16];
#pragma unroll
        for (int r = 0; r < 16; ++r) rli[r] = __builtin_amdgcn_rcpf(wsf[32 + crow(r, hi)]);
        LAS bf16_t* stg = (LAS bf16_t*)(shm + L_OST) + wid * 2048;
#pragma unroll
        for (int r = 0; r < 16; ++r) { const int orow = crow(r, hi);
#pragma unroll
            for (int d0 = 0; d0 < 2; ++d0) { const float v = o[d0][r] * rli[r]; stg[orow * 64 + d0 * 32 + r32] = (bf16_t)(pg8::cvt_pk_bf16(v, v) & 0xffffu); } }
#pragma unroll
        for (int i = 0; i < 4; ++i) { const int row = i * 8 + (lane >> 3), ch = lane & 7; const u32x4 v = *(const LAS u32x4*)(stg + row * 64 + ch * 8); *(u32x4*)(Ow + (size_t)row * qpitch + ch * 8) = v; }
    }
    asm volatile("s_waitcnt lgkmcnt(0)\n\ts_barrier" ::: "memory");
#undef DMA_KV
}
#undef ATT_WAIT_BAR
}

#define XB_TMO      128
#define XB_XCNT(j)  (256  + 64 * (j))
#define XB_XSUB(j)  (1280 + 64 * (j))
#define XB_XGEN(j)  (2304 + 64 * (j))
#define XB_TOP      3328
#define XB_TOPGEN   3392
#define XCD_BAR_WORDS 3456
#define XB_SPIN_CAP (1u << 18)
__device__ __forceinline__ unsigned xb_ld(unsigned* p)              { return __hip_atomic_load(p, __ATOMIC_RELAXED, __HIP_MEMORY_SCOPE_AGENT); }
__device__ __forceinline__ unsigned xb_add(unsigned* p, unsigned v) { return __hip_atomic_fetch_add(p, v, __ATOMIC_RELAXED, __HIP_MEMORY_SCOPE_AGENT); }
__device__ __forceinline__ unsigned xb_xcc_id() { return (unsigned)__builtin_amdgcn_s_getreg((3 << 11) | 20) & 0xFu; }
#define XB_SPIN(cond, bar) do { unsigned _sp = 0; while (cond) { __builtin_amdgcn_s_sleep(1); \
    if ((++_sp & 255u) == 0u) { if (xb_ld(&(bar)[XB_TMO])) break; if (_sp > XB_SPIN_CAP) { atomicAdd(&(bar)[XB_TMO], 1u); break; } } } } while (0)
struct XcdBarrier { unsigned* bar; unsigned x; volatile LAS unsigned* st; };
__device__ __forceinline__ XcdBarrier xcd_barrier_post(unsigned* bar, volatile LAS unsigned* st) {
    XcdBarrier b; b.bar = bar; b.x = xb_xcc_id(); b.st = st;
    if (threadIdx.x == 0) (void)xb_add(&bar[XB_XCNT(b.x)], 1u);
    return b;
}
__device__ __forceinline__ void xcd_barrier_complete(unsigned* bar, unsigned x, unsigned& nloc, unsigned& nx) {
    const unsigned G = gridDim.x * gridDim.y * gridDim.z;
    unsigned sum, cnt, mine, sp = 0u;
    for (;;) {
        sum = 0u; cnt = 0u; mine = 0u;
#pragma unroll
        for (unsigned j = 0; j < 16; ++j) { const unsigned c = xb_ld(&bar[XB_XCNT(j)]); sum += c; cnt += (c > 0u) ? 1u : 0u; mine = (j == x) ? c : mine; }
        if (sum == G) break;
        __builtin_amdgcn_s_sleep(1);
        if ((++sp & 255u) == 0u) { if (xb_ld(&bar[XB_TMO])) break; if (sp > XB_SPIN_CAP) { atomicAdd(&bar[XB_TMO], 1u); break; } }
    }
    nloc = mine > 0u ? mine : 1u; nx = cnt > 0u ? cnt : 1u;
}
__device__ __forceinline__ void xcd_barrier(const XcdBarrier& b) {
    asm volatile("s_waitcnt vmcnt(0)" ::: "memory");
    __syncthreads();
    if (threadIdx.x == 0) {
        unsigned* bar = b.bar;
        __builtin_amdgcn_s_waitcnt(0);
        unsigned nloc = b.st[0], nx = b.st[1];
        if (nloc == 0u) { xcd_barrier_complete(bar, b.x, nloc, nx); b.st[0] = nloc; b.st[1] = nx; }
        const unsigned old = xb_add(&bar[XB_XSUB(b.x)], 1u);
        const unsigned gen = old / nloc;
        if (old + 1u == (gen + 1u) * nloc) {
            __builtin_amdgcn_fence(__ATOMIC_RELEASE, "agent");
            asm volatile("s_waitcnt vmcnt(0)" ::: "memory");
            const unsigned og = xb_add(&bar[XB_TOP], 1u);
            const unsigned tg = og / nx;
            if (og + 1u == (tg + 1u) * nx) xb_add(&bar[XB_TOPGEN], 1u);
            else XB_SPIN(xb_ld(&bar[XB_TOPGEN]) == tg, bar);
            __builtin_amdgcn_fence(__ATOMIC_ACQUIRE, "agent");
            xb_add(&bar[XB_XGEN(b.x)], 1u);
            asm volatile("s_waitcnt vmcnt(0)" ::: "memory");
        } else {
            XB_SPIN(xb_ld(&bar[XB_XGEN(b.x)]) == gen, bar);
            __builtin_amdgcn_fence(__ATOMIC_ACQUIRE, "agent");
            asm volatile("s_waitcnt vmcnt(0)" ::: "memory");
        }
    }
    __syncthreads();
}

#define LDS_WAIT() asm volatile("s_waitcnt lgkmcnt(0)" ::: "memory")
__device__ __forceinline__ unsigned f2bf(float f) { unsigned u = __builtin_bit_cast(unsigned, f); return (u + 0x7fffu + ((u >> 16) & 1u)) >> 16; }
__device__ __forceinline__ unsigned pk2(float lo, float hi) { return pg8::cvt_pk_bf16(lo, hi); }
__device__ __forceinline__ float wave_sum(float v) {
#pragma unroll
    for (int o = 1; o < 64; o <<= 1) v += __shfl_xor(v, o);
    return v;
}
__device__ __forceinline__ void transpose_item(const float* W, int ldw, int K, bf16_t* WT, int dest_row, int k0, int n0, LAS float* scr, int lane) {
#pragma unroll 8
    for (int i = 0; i < 32; ++i) { const int kk = 2 * i + (lane >> 5); scr[kk * 33 + (lane & 31)] = W[(size_t)(k0 + kk) * ldw + n0 + (lane & 31)]; }
    LDS_WAIT(); asm volatile("" ::: "memory");
    const int c = lane & 7;
#pragma unroll
    for (int j = 0; j < 4; ++j) { const int n = (lane >> 3) + 8 * j; const LAS float* s = scr + (8 * c) * 33 + n;
        u32x4 o; o.x = pk2(s[0 * 33], s[1 * 33]); o.y = pk2(s[2 * 33], s[3 * 33]); o.z = pk2(s[4 * 33], s[5 * 33]); o.w = pk2(s[6 * 33], s[7 * 33]);
        *(u32x4*)(WT + (size_t)(dest_row + n) * K + k0 + 8 * c) = o; }
    LDS_WAIT(); asm volatile("" ::: "memory");
}
template <bool GATE>
__device__ __forceinline__ bool transpose_family(int& r, const float* W, int ldw, size_t sstride, int K, int N, int cnt, bf16_t* WT, LAS float* scr, int lane) {
    const int per = (K / 64) * (N / 32);
    if (r >= per * cnt) { r -= per * cnt; return false; }
    const int mi = r / per, it = r % per, nblk = N / 32, kb = it / nblk, nb = it % nblk, n0 = 32 * nb;
    int dest = n0;
    if (GATE) { const int ch = n0 & 255; dest = (ch >> 7) * 256 + ((n0 >> 8) ? 128 : 0) + (ch & 127); }
    transpose_item(W + (size_t)mi * sstride, ldw, K, WT + (size_t)mi * N * K, dest, 64 * kb, n0, scr, lane);
    return true;
}
__device__ __forceinline__ void ln_row(f32x4 (&v)[4], const float* g, const float* b, int lane) {
    float s = 0.f;
#pragma unroll
    for (int j = 0; j < 4; ++j) s += (v[j].x + v[j].y) + (v[j].z + v[j].w);
    const float mean = wave_sum(s) * (1.f / D); float s2 = 0.f;
#pragma unroll
    for (int j = 0; j < 4; ++j) { v[j] = v[j] - mean; s2 += (v[j].x * v[j].x + v[j].y * v[j].y) + (v[j].z * v[j].z + v[j].w * v[j].w); }
    const float rstd = 1.f / sqrtf(wave_sum(s2) * (1.f / D) + LN_EPS);
#pragma unroll
    for (int j = 0; j < 4; ++j) { const f32x4 gg = *(const f32x4*)(g + 4 * lane + 256 * j), bb = *(const f32x4*)(b + 4 * lane + 256 * j); v[j] = v[j] * rstd * gg + bb; }
}
__device__ __forceinline__ void store_row_bf16(bf16_t* orow, const f32x4 (&v)[4], int lane) {
    u32x2* o8 = (u32x2*)orow + lane;
#pragma unroll
    for (int j = 0; j < 4; ++j) { u32x2 w; w.x = pk2(v[j].x, v[j].y); w.y = pk2(v[j].z, v[j].w); o8[64 * j] = w; }
}

constexpr int RING_BYTES = 131072, LDSCTL_OFF = RING_BYTES, MISC_OFF = LDSCTL_OFF + 320, LDS_BYTES = 147456;
constexpr int NPH = 36;
struct Args { const float* in[27]; float* out; unsigned char* ws; int ph_lo, ph_hi; };
enum { I_XP = 0, I_XS, I_RGCONV, I_RGH, I_CSWAK, I_CSWAV, I_CFOXK, I_CFOXV, I_CFOXF, I_LNG, I_LNB, I_WUP, I_WDOWN, I_RGWIN, I_RGCONVW, I_RGCONVB, I_RGGATEW, I_RGGATEB,
       I_RGLAM, I_RGWOUT, I_SWAQKV, I_SWASINK, I_SWAWOUT, I_RELTAB, I_FOXWIN, I_FOXBF, I_FOXWOUT };

__global__ void __launch_bounds__(512, 2) fwd_megakernel(Args args) {
    extern __shared__ __attribute__((aligned(16))) unsigned char lds_raw[];
    LAS unsigned char* lds = (LAS unsigned char*)lds_raw;
    volatile LAS unsigned* MISC = (volatile LAS unsigned*)(lds + MISC_OFF);
    const int G = gridDim.x, NGW = G * 8;
    unsigned* ctl = (unsigned*)(args.ws + WS_CTL);
    for (int u = threadIdx.x; u < (LDS_BYTES - LDSCTL_OFF) / 4; u += 512) ((LAS unsigned*)(lds + LDSCTL_OFF))[u] = 0u;
    __syncthreads();
    XcdBarrier bar; bar.bar = ctl + CW_BAR; bar.x = 0; bar.st = nullptr;
    if (!MK_PER_PHASE) bar = xcd_barrier_post(ctl + CW_BAR, MISC + 8);
    const int lo = args.ph_lo, hi = args.ph_hi;

#define WUP ((bf16_t*)(args.ws + WS_WUP))
#define WDOWN ((bf16_t*)(args.ws + WS_WDOWN))
#define WRGIN ((bf16_t*)(args.ws + WS_WRGIN))
#define WRGGATE ((bf16_t*)(args.ws + WS_WRGGATE))
#define WRGOUT ((bf16_t*)(args.ws + WS_WRGOUT))
#define WSWAQKV ((bf16_t*)(args.ws + WS_WSWAQKV))
#define WSWAOUT ((bf16_t*)(args.ws + WS_WSWAOUT))
#define WFOXIN ((bf16_t*)(args.ws + WS_WFOXIN))
#define WFOXOUT ((bf16_t*)(args.ws + WS_WFOXOUT))
#define XN ((bf16_t*)(args.ws + WS_XN))
#define X (args.out + O_Y)
#define CHA ((float*)(args.ws + WS_CHA))
#define CHB ((float*)(args.ws + WS_CHB))
#define LOGF ((float*)(args.ws + WS_LOGF))
#define SP8 ((float*)(args.ws + WS_SP8))
#define CK2P ((float*)(args.ws + WS_CK2P))
#define CK2S ((float*)(args.ws + WS_CK2S))
#define KSW ((bf16_t*)(args.ws + WS_KSW))
#define VSW ((bf16_t*)(args.ws + WS_VSW))
#define HB ((bf16_t*)(args.ws + WS_H))
#define GB ((bf16_t*)(args.ws + WS_G))
#define UB ((float*)(args.ws + WS_U))
#define AB ((float*)(args.ws + WS_U))
#define CONVB ((bf16_t*)(args.ws + WS_CONV))
#define HG ((bf16_t*)(args.ws + WS_CONV))
#define BB ((float*)(args.ws + WS_B))
#define QB ((bf16_t*)(args.ws + WS_Q))
#define KF ((bf16_t*)(args.ws + WS_KF))
#define VF ((bf16_t*)(args.ws + WS_VF))
#define OUT (args.out)
    int ph = 0;
#define PH_BEGIN if (ph >= lo && ph < hi) { int bx = blockIdx.x; asm volatile("" : "+s"(bx)); int tid = threadIdx.x; asm volatile("" : "+v"(tid)); const int lane = tid & 63; const int wave = __builtin_amdgcn_readfirstlane(tid >> 6); const int vcu = (G % 8 == 0) ? (bx % 8) * (G / 8) + bx / 8 : bx; const int gw = vcu * 8 + wave; (void)gw; (void)lane;
#define PH_END   if (ph + 1 < hi) xcd_barrier(bar); } ++ph;

    PH_BEGIN if (EN(0))
    {
        LAS float* scr = (LAS float*)(lds + wave * 16384);
        constexpr int NITEMS = (45 * 1024 * 1024 + 512 * 1024) / 2048;
        for (int it = gw; it < NITEMS; it += NGW) {
            int r = it;
            if (transpose_family<false>(r, args.in[I_WUP], FF, (size_t)D * FF, D, FF, 4, WUP, scr, lane)) continue;
            if (transpose_family<false>(r, args.in[I_WDOWN], D, (size_t)D * FF, FF, D, 4, WDOWN, scr, lane)) continue;
            if (transpose_family<false>(r, args.in[I_RGWIN], 2 * D, (size_t)D * 2 * D, D, 2 * D, 2, WRGIN, scr, lane)) continue;
            if (transpose_family<true>(r, args.in[I_RGGATEW], 512, (size_t)256 * 512, 256, 512, 8, WRGGATE, scr, lane)) continue;
            if (transpose_family<false>(r, args.in[I_RGWOUT], D, (size_t)D * D, D, D, 2, WRGOUT, scr, lane)) continue;
            if (transpose_family<false>(r, args.in[I_SWAQKV], 1536, 0, D, 1536, 1, WSWAQKV, scr, lane)) continue;
            if (transpose_family<false>(r, args.in[I_SWAWOUT], D, 0, D, D, 1, WSWAOUT, scr, lane)) continue;
            if (transpose_family<false>(r, args.in[I_FOXWIN], 3088, 0, D, 3072, 1, WFOXIN, scr, lane)) continue;
            transpose_family<false>(r, args.in[I_FOXWOUT], D, 0, D, D, 1, WFOXOUT, scr, lane);
        }
        for (int m = gw; m < M; m += NGW) {
            const float* xr = (m < MP) ? args.in[I_XP] + (size_t)m * D : args.in[I_XS] + (size_t)(m - MP) * D;
            f32x4 v[4];
#pragma unroll
            for (int j = 0; j < 4; ++j) v[j] = *(const f32x4*)(xr + 4 * lane + 256 * j);
#pragma unroll
            for (int j = 0; j < 4; ++j) *(f32x4*)(X + (size_t)m * D + 4 * lane + 256 * j) = v[j];
            store_row_bf16(XN + (size_t)m * D, v, lane);
        }
        for (int i = gw * 64 + lane; i < 2 * BS * WIN * 64; i += NGW * 64) {
            const int which = i / (BS * WIN * 64), e = i % (BS * WIN * 64), b = e / (WIN * 64), r = (e / 64) % WIN, c = (e % 64) * 4;
            const float* src = args.in[which ? I_CSWAV : I_CSWAK] + (size_t)e * 4;
            const f32x4 v = *(const f32x4*)src;
            bf16_t* dst = (which ? VSW : KSW) + (size_t)(MP + b * 192 + r) * 256 + c;
            u32x2 w; w.x = pk2(v.x, v.y); w.y = pk2(v.z, v.w); *(u32x2*)dst = w;
            if (r >= 64) *(f32x4*)(OUT + (which ? O_SWAV_S : O_SWAK_S) + (size_t)(b * WIN + r - 64) * 256 + c) = v;
        }
    }
    PH_END

#pragma nounroll
    for (int layer = 0; layer < DEPTH; ++layer) {
        const int kind = layer % 3, j = layer / 3;
#pragma nounroll
        for (int half = 0; half < 2; ++half) {
            const bf16_t* resA; const bf16_t* resW; int resK;
            if (half == 0) {
                if (kind == 0) {
                    PH_BEGIN if (EN(1))
                    { pg8::Gemm g{XN, WRGIN + (size_t)j * 2 * D * D, M, 2 * D, D, D, 1 << 20, 0}; pg8::StaticOrder S; S.init(M, 2 * D, G, bx);
                      pg8::EpiRgIn E{GB, UB}; pg8::gemm_phase<pg8::EpiRgIn, true>(lds, g, S, E); }
                    PH_END
                    PH_BEGIN if (EN(2))
                    {
                        const float* cw = args.in[I_RGCONVW] + (size_t)j * 4 * D; const float* cb = args.in[I_RGCONVB] + (size_t)j * D;
                        if (vcu == 0) for (int c = tid; c < D; c += 512) SP8[c] = 8.0f * log1pf(expf(-args.in[I_RGLAM][(size_t)j * D + c]));
                        for (int m = gw; m < M; m += NGW) {
                            int b, t, T; const float* st = nullptr; float* oc;
                            if (m < MP) { b = m >> 12; t = m & (TP - 1); T = TP; oc = OUT + O_RGCONV_P + (size_t)(j * BP + b) * 3 * D; }
                            else { const int rs = m - MP; b = rs >> 6; t = rs & 63; T = TS; st = args.in[I_RGCONV] + (size_t)(j * BS + b) * 3 * D; oc = OUT + O_RGCONV_S + (size_t)(j * BS + b) * 3 * D; }
#pragma unroll
                            for (int jj = 0; jj < 4; ++jj) { const int c = 4 * lane + 256 * jj;
                                f32x4 acc = *(const f32x4*)(cb + c); f32x4 ucur;
#pragma unroll
                                for (int k = 0; k < 4; ++k) { const int tt = t - 3 + k; f32x4 uv;
                                    if (tt >= 0) uv = *(const f32x4*)(UB + (size_t)(m - 3 + k) * D + c);
                                    else if (st) uv = *(const f32x4*)(st + (size_t)(tt + 3) * D + c);
                                    else uv = (f32x4){0.f, 0.f, 0.f, 0.f};
                                    acc += uv * *(const f32x4*)(cw + k * D + c); if (k == 3) ucur = uv; }
                                u32x2 w; w.x = pk2(acc.x, acc.y); w.y = pk2(acc.z, acc.w); *(u32x2*)(CONVB + (size_t)m * D + c) = w;
                                if (t >= T - 3) *(f32x4*)(oc + (size_t)(t - (T - 3)) * D + c) = ucur; }
                        }
                    }
                    PH_END
                    PH_BEGIN if (EN(3))
                    { pg8::Gemm g{CONVB, WRGGATE + (size_t)j * 2048 * 256, M, 2048, 256, D, 2, 256}; pg8::StaticOrder S; S.init(M, 2048, G, bx);
                      pg8::EpiGates E{args.in[I_RGGATEB] + (size_t)j * 2048, SP8, CONVB, AB, BB}; pg8::gemm_phase<pg8::EpiGates, true>(lds, g, S, E); }
                    PH_END
                    PH_BEGIN if (EN(4))
                    {
                        for (int it = bx; it < 272 * 2; it += G) { const int chunk = it >> 1, ch = (it & 1) * 512 + tid; const size_t base = (size_t)chunk * 64 * D + ch;
                            float P = 1.f, Sv = 0.f;
#pragma unroll 8
                            for (int t = 0; t < 64; ++t) { const float a = AB[base + (size_t)t * D], b = BB[base + (size_t)t * D]; Sv = a * Sv + b; P *= a; }
                            CHA[chunk * D + ch] = P; CHB[chunk * D + ch] = Sv; }
                    }
                    PH_END
                    PH_BEGIN if (EN(5))
                    {
                        for (int it = bx; it < 272 * 2; it += G) { const int chunk = it >> 1, ch = (it & 1) * 512 + tid; const size_t base = (size_t)chunk * 64 * D + ch;
                            float h; bool lastc; float* oh;
                            if (chunk < 256) { const int b = chunk >> 6, c = chunk & 63; h = 0.f;
                                for (int cc = 0; cc < c; ++cc) h = CHA[(b * 64 + cc) * D + ch] * h + CHB[(b * 64 + cc) * D + ch];
                                lastc = (c == 63); oh = OUT + O_RGH_P + (size_t)(j * BP + b) * D + ch; }
                            else { const int b = chunk - 256; h = args.in[I_RGH][(size_t)(j * BS + b) * D + ch]; lastc = true; oh = OUT + O_RGH_S + (size_t)(j * BS + b) * D + ch; }
#pragma unroll 8
                            for (int t = 0; t < 64; ++t) { const float a = AB[base + (size_t)t * D], b = BB[base + (size_t)t * D]; h = a * h + b;
                                const float gt = __uint_as_float((unsigned)GB[base + (size_t)t * D] << 16); HG[base + (size_t)t * D] = (bf16_t)f2bf(h * gt); }
                            if (lastc) *oh = h; }
                    }
                    PH_END
                    resA = HG; resW = WRGOUT + (size_t)j * D * D; resK = D;
                } else if (kind == 1) {
                    PH_BEGIN if (EN(6))
                    { pg8::Gemm g{XN, WSWAQKV, M, 1536, D, D, 1 << 20, 0}; pg8::StaticOrder S; S.init(M, 1536, G, bx);
                      pg8::EpiSwaQkv E{QB, KSW, VSW, OUT + O_SWAK_P, OUT + O_SWAK_S, OUT + O_SWAV_P, OUT + O_SWAV_S}; pg8::gemm_phase<pg8::EpiSwaQkv, true>(lds, g, S, E); }
                    PH_END
                    PH_BEGIN if (EN(7))
                    {
                        LAS float* tbl = (LAS float*)(lds + att::L_AUX);
                        for (int i = tid; i < 16 * 256; i += 512) { const int h = i >> 8, idx = i & 255; const int rel = idx - 191; const int n = rel < 0 ? -rel : rel;
                            int val; if (n < 8) val = n; else { val = 2 + (31 - __builtin_clz((unsigned)(n * n))); if (val > 15) val = 15; }
                            const int bucket = (rel > 0 ? 16 : 0) + val;
                            tbl[i] = (idx < 255) ? args.in[I_RELTAB][bucket * NH + h] * LOG2E : 0.f; }
                        __syncthreads();
                        for (int u = vcu; u < 1088; u += G) {
                            int m0, kr0, t0, kvh;
                            if (u < 1024) { const int b = u >> 8, c = (u >> 2) & 63; kvh = u & 3; m0 = b * TP + c * 64; kr0 = b * TP + (c - 2) * 64; t0 = c >= 2 ? 0 : 2 - c; }
                            else { const int us = u - 1024, b = us >> 2; kvh = us & 3; m0 = MP + b * 64; kr0 = MP + b * 192; t0 = 0; }
                            const int hd = kvh * 4 + (wave >> 1); const int mw = m0 + (wave & 1) * 32;
                            const float sink2 = args.in[I_SWASINK][hd] * LOG2E;
                            att::attn_unit<1>(lds, QB + (size_t)mw * D + hd * 64, QB + (size_t)mw * D + hd * 64, D, KSW + (ptrdiff_t)kr0 * 256 + kvh * 64, VSW + (ptrdiff_t)kr0 * 256 + kvh * 64, 256,
                                              t0, 3, true, (wave & 1) * 32, nullptr, 0, sink2, hd * 1024);
                        }
                    }
                    PH_END
                    resA = QB; resW = WSWAOUT; resK = D;
                } else {
                    PH_BEGIN if (EN(8))
                    { pg8::Gemm g{XN, WFOXIN, M, 3072, D, D, 1 << 20, 0}; pg8::StaticOrder S; S.init(M, 3072, G, bx);
                      pg8::EpiFoxIn E{QB, KF, VF, OUT + O_FOXK, OUT + O_FOXV}; pg8::gemm_phase<pg8::EpiFoxIn, true>(lds, g, S, E); }
                    PH_END
                    PH_BEGIN if (EN(9))
                    {
                        for (int s = gw; s < 64 + 256; s += NGW) {
                            if (s < 64) { const int b = s >> 4, h = s & 15; const float* src = LOGF + ((size_t)b * TP + 64 * lane) * NH + h;
                                float sum = 0.f;
                                for (int i = 0; i < 64; ++i) sum += src[(size_t)i * NH];
                                float incl = sum;
#pragma unroll
                                for (int o = 1; o < 64; o <<= 1) { const float v = __shfl_up(incl, o); if (lane >= o) incl += v; }
                                float run = incl - sum; float* dst = CK2P + (size_t)s * TP + 64 * lane;
                                for (int i = 0; i < 64; ++i) { run += src[(size_t)i * NH]; dst[i] = run * LOG2E; } }
                            else { const int ss = s - 64, b = ss >> 4, h = ss & 15; const float* cf = args.in[I_CFOXF] + (size_t)b * PAST * NH + h; const float* nf = LOGF + (size_t)(MP + b * 64) * NH + h;
                                float sum = 0.f;
                                for (int i = 0; i < 17; ++i) { const int p = 17 * lane + i; sum += (p < PAST) ? cf[(size_t)p * NH] : nf[(size_t)(p - PAST) * NH]; }
                                float incl = sum;
#pragma unroll
                                for (int o = 1; o < 64; o <<= 1) { const float v = __shfl_up(incl, o); if (lane >= o) incl += v; }
                                float run = incl - sum; float* dst = CK2S + (size_t)ss * 1088 + 17 * lane;
                                for (int i = 0; i < 17; ++i) { const int p = 17 * lane + i; run += (p < PAST) ? cf[(size_t)p * NH] : nf[(size_t)(p - PAST) * NH]; dst[i] = run * LOG2E; } }
                        }
                    }
                    PH_END
                    PH_BEGIN if (EN(10))
                    {
                        for (int i = 0; ; ++i) {
                            const int u = i * G + vcu; if (u >= 1024 + 256) break;
                            if (u < 1024) { const int uu = u & 255, ii = u >> 8, bh = uu >> 2, s0 = 2 * (uu & 3); const int qb = (ii == 0) ? s0 : (ii == 1) ? 15 - s0 : (ii == 2) ? s0 + 1 : 14 - s0;
                                const int b = bh >> 4, h = bh & 15; const size_t mw = (size_t)b * TP + 256 * qb + 32 * wave;
                                att::attn_unit<0>(lds, QB + mw * D + h * 64, QB + mw * D + h * 64, D, KF + (size_t)b * TP * D + h * 64, VF + (size_t)b * TP * D + h * 64, D,
                                                  0, 4 * qb + 4, true, 256 * qb + 32 * wave, CK2P + (size_t)bh * TP, 256 * (qb + 1), -INFINITY, 0); }
                            else { const int us = u - 1024, b = us >> 4, h = us & 15; const size_t mw = (size_t)MP + b * 64 + 32 * (wave & 1);
                                att::attn_unit<0>(lds, QB + mw * D + h * 64, QB + mw * D + h * 64, D, KF + (size_t)(MP + b * 1088) * D + h * 64, VF + (size_t)(MP + b * 1088) * D + h * 64, D,
                                                  0, 17, wave < 2, PAST + 32 * wave, CK2S + (size_t)us * 1088, 1088, -INFINITY, 0); }
                        }
                    }
                    PH_END
                    resA = QB; resW = WFOXOUT; resK = D;
                }
            } else {
                PH_BEGIN if (EN(11))
                { pg8::Gemm g{XN, WUP + (size_t)layer * D * FF, M, FF, D, D, 1 << 20, 0}; pg8::StaticOrder S; S.init(M, FF, G, bx);
                  pg8::EpiSqRelu E{HB}; pg8::gemm_phase<pg8::EpiSqRelu, true>(lds, g, S, E); }
                PH_END
                resA = HB; resW = WDOWN + (size_t)layer * D * FF; resK = FF;
            }
            PH_BEGIN if (EN(12))
            { pg8::Gemm g{resA, resW, M, D, resK, resK, 1 << 20, 0}; pg8::StaticOrder S; S.init(M, D, G, bx);
              pg8::EpiResid E{X}; pg8::gemm_phase<pg8::EpiResid, true>(lds, g, S, E); }
            PH_END
            PH_BEGIN if (EN(13))
            {
                const float* lg = args.in[I_LNG] + (size_t)(layer * 2 + half) * D; const float* lb = args.in[I_LNB] + (size_t)(layer * 2 + half) * D;
                const bool fox_next = (layer == 1 && half == 1);
                LAS float* wfl = (LAS float*)lds;
                if (fox_next) {
                    for (int k = tid; k < D; k += 512) { const float* s = args.in[I_FOXWIN] + (size_t)k * 3088 + 3072; LAS float* d = wfl + ((k & 3) * 256 + (k >> 2)) * 20;
#pragma unroll
                        for (int q = 0; q < 4; ++q) *(LAS f32x4*)(d + 4 * q) = *(const f32x4*)(s + 4 * q); }
                    __syncthreads();
                }
                for (int m = gw; m < M; m += NGW) {
                    f32x4 v[4];
#pragma unroll
                    for (int jj = 0; jj < 4; ++jj) v[jj] = *(const f32x4*)(X + (size_t)m * D + 4 * lane + 256 * jj);
                    ln_row(v, lg, lb, lane);
#pragma unroll
                    for (int jj = 0; jj < 4; ++jj) *(f32x4*)(X + (size_t)m * D + 4 * lane + 256 * jj) = v[jj];
                    store_row_bf16(XN + (size_t)m * D, v, lane);
                    if (fox_next) {
                        f32x4 dacc[4] = {{0.f, 0.f, 0.f, 0.f}, {0.f, 0.f, 0.f, 0.f}, {0.f, 0.f, 0.f, 0.f}, {0.f, 0.f, 0.f, 0.f}};
#pragma unroll
                        for (int jj = 0; jj < 4; ++jj)
#pragma unroll
                            for (int e = 0; e < 4; ++e) { const LAS float* wr_ = wfl + (e * 256 + 64 * jj + lane) * 20; const float xv = v[jj][e];
#pragma unroll
                                for (int q = 0; q < 4; ++q) dacc[q] += xv * *(const LAS f32x4*)(wr_ + 4 * q); }
                        float mine = 0.f;
#pragma unroll
                        for (int q = 0; q < 4; ++q)
#pragma unroll
                            for (int e = 0; e < 4; ++e) { const float sfull = wave_sum(dacc[q][e]); if (lane == 4 * q + e) mine = sfull; }
                        if (lane < NH) { const float z = mine + args.in[I_FOXBF][lane]; const float lf = fminf(z, 0.f) - log1pf(__expf(-fabsf(z)));
                            LOGF[(size_t)m * NH + lane] = lf; OUT[O_FOXF + (size_t)m * NH + lane] = lf; }
                    }
                }
                if (fox_next) {
                    for (size_t i = (size_t)gw * 64 + lane; i < (size_t)2 * BS * PAST * (D / 8); i += (size_t)NGW * 64) {
                        const int which = (int)(i / ((size_t)BS * PAST * (D / 8))); const size_t e = i % ((size_t)BS * PAST * (D / 8)); const int b = (int)(e / (PAST * (D / 8))), pos = (int)((e / (D / 8)) % PAST), c = (int)(e % (D / 8)) * 8;
                        const float* src = args.in[which ? I_CFOXV : I_CFOXK] + e * 8;
                        const f32x4 v0 = *(const f32x4*)src, v1 = *(const f32x4*)(src + 4);
                        *(u32x4*)((which ? VF : KF) + (size_t)(MP + b * 1088 + pos) * D + c) = pg8::pack8(v0, v1);
                    }
                }
            }
            PH_END
        }
    }
#undef PH_BEGIN
#undef PH_END
}

extern "C" void kernel_launch(void* const* d_in, const int* in_sizes, int n_in, void* d_out, int out_size, void* d_ws, size_t ws_size, hipStream_t stream) {
    static int grid = 0;
    if (grid == 0) {
        if (n_in != 27 || in_sizes[0] != MP * D || (size_t)out_size != O_END || ws_size < WS_END) {
            fprintf(stderr, "kernel_launch: unexpected problem: n_in %d in0 %d out %d ws %zu (need %zu); nothing launched\n", n_in, n_in > 0 ? in_sizes[0] : -1, out_size, ws_size, (size_t)WS_END); grid = -1; return; }
        int dev = 0, cus = 0, per_cu = 0;
        if (hipGetDevice(&dev) != hipSuccess || hipDeviceGetAttribute(&cus, hipDeviceAttributeMultiprocessorCount, dev) != hipSuccess) { grid = -1; return; }
        if (hipFuncSetAttribute((const void*)fwd_megakernel, hipFuncAttributeMaxDynamicSharedMemorySize, LDS_BYTES) != hipSuccess) { fprintf(stderr, "kernel_launch: hipFuncSetAttribute failed\n"); grid = -1; return; }
        if (hipOccupancyMaxActiveBlocksPerMultiprocessor(&per_cu, (const void*)fwd_megakernel, 512, LDS_BYTES) != hipSuccess || per_cu < 1) {
            fprintf(stderr, "kernel_launch: occupancy query reports %d workgroups per CU; nothing launched\n", per_cu); (void)hipGetLastError(); grid = -1; return; }
        (void)hipGetLastError();
        grid = cus;
    }
    if (grid < 0) return;
    if (hipMemsetAsync((char*)d_ws + WS_CTL, 0, CTL_ZERO_BYTES, stream) != hipSuccess) { fprintf(stderr, "kernel_launch: memset failed\n"); return; }
    Args a{};
    for (int i = 0; i < 27; ++i) a.in[i] = (const float*)d_in[i];
    a.out = (float*)d_out; a.ws = (unsigned char*)d_ws;
#if MK_PER_PHASE
    for (int p = 0; p < NPH; ++p) { a.ph_lo = p; a.ph_hi = p + 1; hipLaunchKernelGGL(fwd_megakernel, dim3(grid), dim3(512), LDS_BYTES, stream, a); }
#else
    a.ph_lo = 0; a.ph_hi = NPH;
    hipLaunchKernelGGL(fwd_megakernel, dim3(grid), dim3(512), LDS_BYTES, stream, a);
#endif
    const hipError_t le = hipPeekAtLastError();
    if (le != hipSuccess) fprintf(stderr, "kernel_launch: launch failed: %s\n", hipGetErrorName(le));
}
```

```cpp
#include <hip/hip_runtime.h>
#include <cstdio>
#include <cstdint>
#include <cmath>

#ifndef MK_PER_PHASE
#define MK_PER_PHASE 0
#endif

#ifndef ENMASK
#define ENMASK 0xFFFFFFFFu
#endif
#define EN(id) (((ENMASK) >> (id)) & 1u)
#ifndef REPMASK
#define REPMASK 0u
#endif
#ifndef XBAR
#define XBAR 0
#endif
#define NREP(id) (1 + (int)(((REPMASK) >> (id)) & 1u))
#define LAS __attribute__((address_space(3)))
#define GAS __attribute__((address_space(1)))
typedef unsigned short bf16_t;
typedef short bf16x8 __attribute__((ext_vector_type(8)));
typedef short s16x4 __attribute__((ext_vector_type(4)));
typedef float f32x4 __attribute__((ext_vector_type(4)));
typedef float f32x2 __attribute__((ext_vector_type(2)));
typedef float f32x16 __attribute__((ext_vector_type(16)));
typedef unsigned u32x4 __attribute__((ext_vector_type(4)));
typedef unsigned u32x2 __attribute__((ext_vector_type(2)));
typedef __bf16 bf16x2_t __attribute__((ext_vector_type(2)));

constexpr int D = 1024, FF = 4096, NH = 16, HD = 64, KVH = 4;
constexpr int BP = 4, TP = 4096, BS = 16, TS = 64, PAST = 1024, WIN = 128;
constexpr int MP = BP * TP, MS = BS * TS, M = MP + MS;
constexpr int DEPTH = 4;
constexpr float ALPHA = 1.6817928305074290f;
constexpr float LN_EPS = 1e-5f;
constexpr float LOG2E = 1.4426950408889634f;
constexpr float C2 = 0.125f * LOG2E;
constexpr int KSW_ROWS = MP + BS * 192;
constexpr int KFX_ROWS = MP + BS * 1088;

constexpr size_t O_Y = 0;
constexpr size_t O_RGCONV_P = (size_t)M * D;
constexpr size_t O_RGCONV_S = O_RGCONV_P + 2 * BP * 3 * D;
constexpr size_t O_RGH_P = O_RGCONV_S + 2 * BS * 3 * D;
constexpr size_t O_RGH_S = O_RGH_P + 2 * BP * D;
constexpr size_t O_SWAK_P = O_RGH_S + 2 * BS * D;
constexpr size_t O_SWAK_S = O_SWAK_P + (size_t)BP * WIN * 256;
constexpr size_t O_SWAV_P = O_SWAK_S + (size_t)BS * WIN * 256;
constexpr size_t O_SWAV_S = O_SWAV_P + (size_t)BP * WIN * 256;
constexpr size_t O_FOXK = O_SWAV_S + (size_t)BS * WIN * 256;
constexpr size_t O_FOXV = O_FOXK + (size_t)M * D;
constexpr size_t O_FOXF = O_FOXV + (size_t)M * D;
constexpr size_t O_END = O_FOXF + (size_t)M * NH;
static_assert(O_END == 55230464, "output size");

constexpr size_t MiB = 1u << 20;
constexpr size_t WS_CTL = 0, CTL_ZERO_BYTES = 1 * MiB;
constexpr size_t WS_WUP = 2 * MiB, WS_WDOWN = 34 * MiB, WS_WRGIN = 66 * MiB, WS_WRGGATE = 74 * MiB, WS_WRGOUT = 76 * MiB;
constexpr size_t WS_WSWAQKV = 80 * MiB, WS_WSWAOUT = 83 * MiB, WS_WFOXIN = 85 * MiB, WS_WFOXOUT = 91 * MiB;
constexpr size_t WS_XN = 94 * MiB;
constexpr size_t WS_CHA = 128 * MiB, WS_CHB = 130 * MiB;
constexpr size_t WS_LOGF = 132 * MiB, WS_SP8 = 133 * MiB + 512 * 1024;
constexpr size_t WS_CK2P = 134 * MiB, WS_CK2S = 136 * MiB;
constexpr size_t WS_KSW = 138 * MiB, WS_VSW = 148 * MiB;
constexpr size_t WS_BIG = 160 * MiB;
constexpr size_t WS_H = WS_BIG;
constexpr size_t WS_G = WS_BIG, WS_U = WS_BIG + 34 * MiB, WS_CONV = WS_BIG + 102 * MiB, WS_B = WS_BIG + 136 * MiB;
constexpr size_t WS_Q = WS_BIG, WS_KF = WS_BIG + 34 * MiB, WS_VF = WS_BIG + 100 * MiB;
constexpr size_t WS_O = WS_BIG + 166 * MiB;
constexpr size_t WS_END = WS_BIG + 204 * MiB;
static_assert((size_t)KSW_ROWS * 256 * 2 <= 10 * MiB && (size_t)KFX_ROWS * 1024 * 2 <= 66 * MiB, "kv buffers");

constexpr int CW_BAR = 4096;

namespace pg8 {
constexpr int BM = 256, BK = 64, HALF = 128, HTB = HALF * BK * 2, STAGE_BYTES = 8 * HTB, NXCD = 8, WGM = 8;
__host__ __device__ __forceinline__ int lds_byte(int r, int c) { const int st = (r >> 4) * 2 + (c >> 5), rr = r & 15, cc = c & 31, ob = rr * 64 + cc * 2; return st * 1024 + (ob ^ (((ob >> 9) & 1) << 5)); }
__host__ __device__ __forceinline__ void stage_rc(int b, int& R, int& C) { const int st = b / 1024, sb = b % 1024, swz = sb ^ (((sb >> 9) & 1) << 5); R = (st >> 1) * 16 + swz / 64; C = (st & 1) * 32 + (swz % 64) / 2; }
__host__ __device__ __forceinline__ int perm32(int rho) { const int n = rho >> 4, i = rho & 15; return 8 * (i >> 2) + 4 * n + (i & 3); }

struct Unit { int pm, pn; };
struct Gemm { const bf16_t* A; const bf16_t* Bt; int M, N, K, lda, a_div, a_stride; };

struct StaticOrder {
    int nM, nN, nwg, G, c;
    __host__ __device__ void init(int M_, int N_, int G_, int c_) { nM = M_ / BM; nN = N_ / BM; nwg = nM * nN; G = G_; c = c_; }
    __host__ __device__ bool next(int i, Unit& u) const {
        const long L = (long)i * G + c; if (L >= nwg) return false;
        int wgid = (int)L; { const int q = nwg / NXCD, r = nwg % NXCD, xcd = wgid % NXCD, off = wgid / NXCD; wgid = (xcd < r ? xcd * (q + 1) : r * (q + 1) + (xcd - r) * q) + off; }
        const int nig = WGM * nN, gid = wgid / nig, fm = gid * WGM, gsz = (nM - fm) < WGM ? (nM - fm) : WGM;
        u.pm = fm + ((wgid % nig) % gsz); u.pn = (wgid % nig) / gsz; return true;
    }
};

__device__ __forceinline__ unsigned cvt_pk_bf16(float lo, float hi) { f32x2 v = {lo, hi}; bf16x2_t b = __builtin_convertvector(v, bf16x2_t); return __builtin_bit_cast(unsigned, b); }

template <class Epi, bool ALIGN_EPI>
__device__ __forceinline__ void gemm_phase(LAS unsigned char* lds, const Gemm g, const StaticOrder& S, const Epi& E) {
    int tid = threadIdx.x; asm volatile("" : "+v"(tid));
    const int wid = __builtin_amdgcn_readfirstlane(tid >> 6), lane = tid & 63, wr = wid >> 2, wc = wid & 3, fr = lane & 15, fq = lane >> 4;
    int K = g.K; asm volatile("" : "+s"(K));
    const int nt = K / BK, lda = g.lda;
    unsigned voffA[2], voffB[2];
#pragma unroll
    for (int i = 0; i < 2; ++i) { int R, C; stage_rc(tid * 16 + i * 8192, R, C); const int Rb = Epi::PERM ? ((R & ~31) + perm32(R & 31)) : R;
        voffA[i] = (unsigned)(R * lda + C) * 2u; voffB[i] = (unsigned)(Rb * K + C) * 2u; }
    const size_t kstep = (size_t)(BK * 2);
    const size_t hstepA = (size_t)HALF * lda * 2, tstepA = 2 * hstepA;
    const size_t hstepB = (size_t)HALF * K * 2, tstepB = 2 * hstepB;
    const unsigned ldsw = (unsigned)wid * 1024u;
    const int aoff = lds_byte(wr * 64 + fr, fq * 8), boff = lds_byte(wc * 32 + fr, fq * 8);
#define PG8_SA(b, h) (((b) * 2 + (h)) * HTB)
#define PG8_SB(b, h) ((4 + (b) * 2 + (h)) * HTB)
#define PG8_STAGE(bufoff, gbase, voff) do { const char* _gb = (const char*)(gbase); asm volatile("" : "+s"(_gb)); _Pragma("unroll") for (int _i = 0; _i < 2; ++_i) \
        __builtin_amdgcn_global_load_lds((const unsigned*)(_gb + (voff)[_i]), (LAS unsigned*)(lds + (bufoff) + ldsw + _i * 8192), 16, 0, 0); } while (0)
#define PG8_LDA(dst, b, h) do { _Pragma("unroll") for (int m = 0; m < 4; ++m) _Pragma("unroll") for (int k = 0; k < 2; ++k) dst[m][k] = *(const LAS bf16x8*)(lds + PG8_SA(b, h) + aoff + m * 2048 + k * 1024); } while (0)
#define PG8_LDB(dst, b, h) do { _Pragma("unroll") for (int n = 0; n < 2; ++n) _Pragma("unroll") for (int k = 0; k < 2; ++k) dst[n][k] = *(const LAS bf16x8*)(lds + PG8_SB(b, h) + boff + n * 2048 + k * 1024); } while (0)
#define PG8_MMA(ai, bj, At, Bt) do { __builtin_amdgcn_s_setprio(1); _Pragma("unroll") for (int m = 0; m < 4; ++m) _Pragma("unroll") for (int n = 0; n < 2; ++n) _Pragma("unroll") for (int k = 0; k < 2; ++k) \
        acc[ai][bj][m][n] = __builtin_amdgcn_mfma_f32_16x16x32_bf16(Bt[n][k], At[m][k], acc[ai][bj][m][n], 0, 0, 0); __builtin_amdgcn_s_setprio(0); } while (0)
#define PG8_WAIT_V(n) asm volatile("s_waitcnt vmcnt(" #n ")" ::: "memory")
#define PG8_WAIT_L(n) asm volatile("s_waitcnt lgkmcnt(" #n ")" ::: "memory")
#define PG8_BAR __builtin_amdgcn_s_barrier()
#define PG8_SCHED __builtin_amdgcn_sched_barrier(0)
#define PG8_APTR(u) ((const char*)g.A + (size_t)(u).pm * tstepA + (size_t)(((u).pn / g.a_div) * g.a_stride) * 2)
#define PG8_BPTR(u) ((const char*)g.Bt + (size_t)(u).pn * tstepB)
    Unit cur, nxt; int ui = 0;
    if (!S.next(0, cur)) return;
    f32x4 acc[2][2][4][2];
#pragma unroll
    for (int a = 0; a < 2; ++a)
#pragma unroll
        for (int b = 0; b < 2; ++b)
#pragma unroll
            for (int m = 0; m < 4; ++m)
#pragma unroll
                for (int n = 0; n < 2; ++n) acc[a][b][m][n] = (f32x4){0.f, 0.f, 0.f, 0.f};
    bf16x8 At[4][2], B0[2][2], B1[2][2];
    const char* cA = PG8_APTR(cur); const char* cB = PG8_BPTR(cur);
    PG8_STAGE(PG8_SB(0, 0), cB, voffB); PG8_STAGE(PG8_SB(0, 1), cB + hstepB, voffB); PG8_STAGE(PG8_SA(0, 0), cA, voffA); PG8_STAGE(PG8_SA(0, 1), cA + hstepA, voffA);
    if (wr == 1) PG8_BAR;
    PG8_WAIT_V(2); PG8_BAR;
    PG8_STAGE(PG8_SB(1, 0), cB + kstep, voffB); PG8_STAGE(PG8_SA(1, 0), cA + kstep, voffA); PG8_STAGE(PG8_SB(1, 1), cB + hstepB + kstep, voffB);
    PG8_WAIT_V(6); PG8_BAR;
    for (;;) {
        const bool has_next = S.next(ui + 1, nxt);
        const char* nA = has_next ? PG8_APTR(nxt) : cA; const char* nB = has_next ? PG8_BPTR(nxt) : cB;
        for (int t = 0; t < nt; t += 2) {
            const bool last = (t == nt - 2);
            const char* a1 = cA + (size_t)(t + 1) * kstep;
            const char* a2 = last ? nA : cA + (size_t)(t + 2) * kstep; const char* b2 = last ? nB : cB + (size_t)(t + 2) * kstep;
            const char* a3 = a2 + kstep; const char* b3 = b2 + kstep;
            PG8_LDB(B0, 0, 0); PG8_LDB(B1, 0, 1); PG8_SCHED; PG8_LDA(At, 0, 0); PG8_STAGE(PG8_SA(1, 1), a1 + hstepA, voffA);
            PG8_WAIT_V(8); PG8_WAIT_L(0); PG8_BAR; PG8_MMA(0, 0, At, B0); PG8_MMA(0, 1, At, B1); PG8_BAR; PG8_SCHED;
            PG8_LDA(At, 0, 1); PG8_STAGE(PG8_SB(0, 0), b2, voffB); PG8_STAGE(PG8_SB(0, 1), b2 + hstepB, voffB); PG8_STAGE(PG8_SA(0, 0), a2, voffA);
            PG8_WAIT_V(8); PG8_WAIT_L(0); PG8_BAR; PG8_MMA(1, 0, At, B0); PG8_MMA(1, 1, At, B1); PG8_BAR; PG8_SCHED;
            PG8_LDB(B0, 1, 0); PG8_LDB(B1, 1, 1); PG8_SCHED; PG8_LDA(At, 1, 0); PG8_STAGE(PG8_SA(0, 1), a2 + hstepA, voffA);
            PG8_WAIT_V(8); PG8_WAIT_L(0); PG8_BAR; PG8_MMA(0, 0, At, B0); PG8_MMA(0, 1, At, B1); PG8_BAR; PG8_SCHED;
            PG8_LDA(At, 1, 1); PG8_STAGE(PG8_SB(1, 0), b3, voffB); PG8_STAGE(PG8_SB(1, 1), b3 + hstepB, voffB); PG8_STAGE(PG8_SA(1, 0), a3, voffA);
            PG8_WAIT_V(8); PG8_WAIT_L(0); PG8_BAR; PG8_MMA(1, 0, At, B0); PG8_MMA(1, 1, At, B1); PG8_BAR; PG8_SCHED;
        }
        if constexpr (ALIGN_EPI) { if (wr == 0) PG8_BAR; }
        E(acc, cur, wr, wc, fr, fq);
        if (!has_next) break;
#pragma unroll
        for (int a = 0; a < 2; ++a)
#pragma unroll
            for (int b = 0; b < 2; ++b)
#pragma unroll
                for (int m = 0; m < 4; ++m)
#pragma unroll
                    for (int n = 0; n < 2; ++n) acc[a][b][m][n] = (f32x4){0.f, 0.f, 0.f, 0.f};
        cur = nxt; cA = nA; cB = nB; ++ui;
        if constexpr (ALIGN_EPI) { if (wr == 1) PG8_BAR; }
    }
    PG8_WAIT_V(0);
    if constexpr (!ALIGN_EPI) { if (wr == 0) PG8_BAR; }
    PG8_BAR;
#undef PG8_SA
#undef PG8_SB
#undef PG8_STAGE
#undef PG8_LDA
#undef PG8_LDB
#undef PG8_MMA
#undef PG8_WAIT_V
#undef PG8_WAIT_L
#undef PG8_BAR
#undef PG8_SCHED
#undef PG8_APTR
#undef PG8_BPTR
}

__device__ __forceinline__ float gelu_tanh(float x) {
    const float z = x * (1.0f + 0.044715f * x * x);
    const float e = __builtin_amdgcn_exp2f(z * (-2.0f * 0.7978845608028654f * LOG2E));
    return x * __builtin_amdgcn_rcpf(1.0f + e);
}
__device__ __forceinline__ u32x4 pack8(const f32x4 v0, const f32x4 v1) { u32x4 w; w.x = cvt_pk_bf16(v0[0], v0[1]); w.y = cvt_pk_bf16(v0[2], v0[3]); w.z = cvt_pk_bf16(v1[0], v1[1]); w.w = cvt_pk_bf16(v1[2], v1[3]); return w; }

struct EpiRgIn {
    static constexpr bool PERM = true, PAIRED = false;
    bf16_t* G; float* U;
    __device__ __forceinline__ void small(int row, int col, const f32x4 v0, const f32x4 v1) const {
        if (col >= D) { float* p = U + (size_t)row * D + (col - D); *(f32x4*)p = v0; *(f32x4*)(p + 4) = v1; }
        else { f32x4 g0, g1;
#pragma unroll
            for (int e = 0; e < 4; ++e) { g0[e] = gelu_tanh(v0[e]); g1[e] = gelu_tanh(v1[e]); }
            *(u32x4*)(G + (size_t)row * D + col) = pack8(g0, g1); }
    }
    __device__ __forceinline__ void operator()(const f32x4 (&acc)[2][2][4][2], const Unit& u, int wr, int wc, int fr, int fq) const {
        asm volatile("" : "+v"(fr), "+v"(fq));
        const int row0 = u.pm * BM + wr * 64 + fr; const int colt = u.pn * BM; const bool isU = colt >= D;
        const int col0 = (colt & (D - 1)) + wc * 32 + 8 * fq;
#pragma unroll
        for (int ai = 0; ai < 2; ++ai)
#pragma unroll
            for (int m = 0; m < 4; ++m) { const size_t ro = (size_t)(row0 + ai * HALF + m * 16) * D + col0;
#pragma unroll
                for (int bj = 0; bj < 2; ++bj) { const f32x4 v0 = acc[ai][bj][m][0], v1 = acc[ai][bj][m][1];
                    if (isU) { *(f32x4*)(U + ro + bj * HALF) = v0; *(f32x4*)(U + ro + bj * HALF + 4) = v1; }
                    else { f32x4 g0, g1;
#pragma unroll
                        for (int e = 0; e < 4; ++e) { g0[e] = gelu_tanh(v0[e]); g1[e] = gelu_tanh(v1[e]); }
                        *(u32x4*)(G + ro + bj * HALF) = pack8(g0, g1); } }
                asm volatile("" ::: "memory"); }
    }
};
struct EpiGates {
    static constexpr bool PERM = false, PAIRED = true;
    const float* gate_b; const float* sp8; const bf16_t* CONV; float* Aout; float* Bout;
    __device__ __forceinline__ void small(int row, int ch, const f32x4 r4, const f32x4 i4) const {
        const int nb = ch >> 8, c = ch & 255; const size_t ro = (size_t)row * D + ch;
        const f32x4 rp = r4 + *(const f32x4*)(gate_b + nb * 512 + c), ip = i4 + *(const f32x4*)(gate_b + nb * 512 + 256 + c), s8 = *(const f32x4*)(sp8 + ch);
        const u32x2 cw = *(const u32x2*)(CONV + ro);
        float cv[4]; cv[0] = __uint_as_float(cw.x << 16); cv[1] = __uint_as_float(cw.x & 0xffff0000u); cv[2] = __uint_as_float(cw.y << 16); cv[3] = __uint_as_float(cw.y & 0xffff0000u);
        f32x4 av, bv;
#pragma unroll
        for (int e = 0; e < 4; ++e) {
            const float r = __builtin_amdgcn_rcpf(1.0f + __builtin_amdgcn_exp2f(-LOG2E * rp[e])), ig = __builtin_amdgcn_rcpf(1.0f + __builtin_amdgcn_exp2f(-LOG2E * ip[e]));
            const float la = -r * s8[e]; av[e] = __builtin_amdgcn_exp2f(LOG2E * la);
            const float y = 2.0f * la;
            const float ser = -y * (1.0f + y * (0.5f + y * (0.16666667f + y * 0.041666668f)));
            const float dir = 1.0f - __builtin_amdgcn_exp2f(LOG2E * y);
            const float om = (y > -0.0625f) ? ser : dir;
            bv[e] = __builtin_sqrtf(om) * (ig * cv[e]); }
        *(f32x4*)(Aout + ro) = av; *(f32x4*)(Bout + ro) = bv;
    }
    __device__ __forceinline__ void operator()(const f32x4 (&acc)[2][2][4][2], const Unit& u, int wr, int wc, int fr, int fq) const {
        asm volatile("" : "+v"(fr), "+v"(fq));
        const int nb = u.pn >> 1, pn2 = u.pn & 1; const int row0 = u.pm * BM + wr * 64 + fr;
#pragma unroll
        for (int n = 0; n < 2; ++n) { const int c = pn2 * 128 + wc * 32 + 16 * n + 4 * fq; const int ch = nb * 256 + c;
            const f32x4 gbr = *(const f32x4*)(gate_b + nb * 512 + c), gbi = *(const f32x4*)(gate_b + nb * 512 + 256 + c), s8 = *(const f32x4*)(sp8 + ch);
#pragma unroll
            for (int ai = 0; ai < 2; ++ai)
#pragma unroll
                for (int m = 0; m < 4; ++m) { const size_t ro = (size_t)(row0 + ai * HALF + m * 16) * D + ch;
                    const f32x4 rp = acc[ai][0][m][n] + gbr, ip = acc[ai][1][m][n] + gbi;
                    const u32x2 cw = *(const u32x2*)(CONV + ro);
                    float cv[4]; cv[0] = __uint_as_float(cw.x << 16); cv[1] = __uint_as_float(cw.x & 0xffff0000u); cv[2] = __uint_as_float(cw.y << 16); cv[3] = __uint_as_float(cw.y & 0xffff0000u);
                    f32x4 av, bv;
#pragma unroll
                    for (int e = 0; e < 4; ++e) {
                        const float r = __builtin_amdgcn_rcpf(1.0f + __builtin_amdgcn_exp2f(-LOG2E * rp[e])), ig = __builtin_amdgcn_rcpf(1.0f + __builtin_amdgcn_exp2f(-LOG2E * ip[e]));
                        const float la = -r * s8[e]; av[e] = __builtin_amdgcn_exp2f(LOG2E * la);
                        const float y = 2.0f * la;
                        const float ser = -y * (1.0f + y * (0.5f + y * (0.16666667f + y * 0.041666668f)));
                        const float dir = 1.0f - __builtin_amdgcn_exp2f(LOG2E * y);
                        const float om = (y > -0.0625f) ? ser : dir;
                        bv[e] = __builtin_sqrtf(om) * (ig * cv[e]); }
                    *(f32x4*)(Aout + ro) = av; *(f32x4*)(Bout + ro) = bv;
                    asm volatile("" ::: "memory"); } }
    }
};
struct EpiResid {
    static constexpr bool PERM = false, PAIRED = false;
    float* X;
    __device__ __forceinline__ void small(int row, int col, const f32x4 v0, const f32x4 v1) const {
        f32x4* p = (f32x4*)(X + (size_t)row * D + col); const f32x4 x0 = p[0], x1 = p[1]; p[0] = x0 * ALPHA + v0; p[1] = x1 * ALPHA + v1;
    }
    __device__ __forceinline__ void operator()(const f32x4 (&acc)[2][2][4][2], const Unit& u, int wr, int wc, int fr, int fq) const {
        asm volatile("" : "+v"(fr), "+v"(fq));
        const int row0 = u.pm * BM + wr * 64 + fr, col0 = u.pn * BM + wc * 32 + 4 * fq;
#pragma unroll
        for (int ai = 0; ai < 2; ++ai)
#pragma unroll
            for (int m = 0; m < 4; ++m) { float* xr = X + (size_t)(row0 + ai * HALF + m * 16) * D + col0;
#pragma unroll
                for (int bj = 0; bj < 2; ++bj)
#pragma unroll
                    for (int n = 0; n < 2; ++n) { f32x4* p = (f32x4*)(xr + bj * HALF + n * 16); const f32x4 x = *p; *p = x * ALPHA + acc[ai][bj][m][n]; }
                if (m & 1) asm volatile("" ::: "memory"); }
    }
};
struct EpiSqRelu {
    static constexpr bool PERM = true, PAIRED = false;
    bf16_t* Hb;
    __device__ __forceinline__ void small(int row, int col, f32x4 v0, f32x4 v1) const {
#pragma unroll
        for (int e = 0; e < 4; ++e) { const float a = fmaxf(v0[e], 0.f), b = fmaxf(v1[e], 0.f); v0[e] = a * a; v1[e] = b * b; }
        *(u32x4*)(Hb + (size_t)row * FF + col) = pack8(v0, v1);
    }
    __device__ __forceinline__ void operator()(const f32x4 (&acc)[2][2][4][2], const Unit& u, int wr, int wc, int fr, int fq) const {
        asm volatile("" : "+v"(fr), "+v"(fq));
        const int row0 = u.pm * BM + wr * 64 + fr, col0 = u.pn * BM + wc * 32 + 8 * fq;
#pragma unroll
        for (int ai = 0; ai < 2; ++ai)
#pragma unroll
            for (int m = 0; m < 4; ++m) { bf16_t* hr = Hb + (size_t)(row0 + ai * HALF + m * 16) * FF + col0;
#pragma unroll
                for (int bj = 0; bj < 2; ++bj) { f32x4 v0 = acc[ai][bj][m][0], v1 = acc[ai][bj][m][1];
#pragma unroll
                    for (int e = 0; e < 4; ++e) { const float a = fmaxf(v0[e], 0.f), b = fmaxf(v1[e], 0.f); v0[e] = a * a; v1[e] = b * b; }
                    *(u32x4*)(hr + bj * HALF) = pack8(v0, v1); }
                asm volatile("" ::: "memory"); }
    }
};
struct EpiSwaQkv {
    static constexpr bool PERM = true, PAIRED = false;
    bf16_t* Q; bf16_t* Kb; bf16_t* Vb; float* outKp; float* outKs; float* outVp; float* outVs;
    __device__ __forceinline__ void small(int row, int col, const f32x4 v0, const f32x4 v1) const {
        if (col < D) { *(u32x4*)(Q + (size_t)row * D + col) = pack8(v0 * C2, v1 * C2); return; }
        const bool isK = col < D + 256; const int c = (col - D) & 255; const int rs = row - MP, b = rs >> 6, t = rs & 63;
        *(u32x4*)((isK ? Kb : Vb) + (size_t)(MP + b * 192 + 128 + t) * 256 + c) = pack8(v0, v1);
        float* fo = (isK ? outKs : outVs) + (size_t)(b * WIN + 64 + t) * 256 + c; *(f32x4*)fo = v0; *(f32x4*)(fo + 4) = v1;
    }
    __device__ __forceinline__ void operator()(const f32x4 (&acc)[2][2][4][2], const Unit& u, int wr, int wc, int fr, int fq) const {
        asm volatile("" : "+v"(fr), "+v"(fq));
        const int row0 = u.pm * BM + wr * 64 + fr; const int cl = wc * 32 + 8 * fq;
        if (u.pn < 4) {
#pragma unroll
            for (int ai = 0; ai < 2; ++ai)
#pragma unroll
                for (int m = 0; m < 4; ++m) { bf16_t* qr = Q + (size_t)(row0 + ai * HALF + m * 16) * D + u.pn * BM + cl;
#pragma unroll
                    for (int bj = 0; bj < 2; ++bj) *(u32x4*)(qr + bj * HALF) = pack8(acc[ai][bj][m][0] * C2, acc[ai][bj][m][1] * C2);
                    asm volatile("" ::: "memory"); }
        } else {
            bf16_t* KV = (u.pn == 4) ? Kb : Vb; float* op = (u.pn == 4) ? outKp : outVp; float* os = (u.pn == 4) ? outKs : outVs;
#pragma unroll
            for (int ai = 0; ai < 2; ++ai)
#pragma unroll
                for (int m = 0; m < 4; ++m) { const int row = row0 + ai * HALF + m * 16; int krow; float* fo = nullptr;
                    if (row < MP) { krow = row; const int b = row >> 12, t = row & (TP - 1); if (t >= TP - WIN) fo = op + (size_t)(b * WIN + (t - (TP - WIN))) * 256; }
                    else { const int rs = row - MP, b = rs >> 6, t = rs & 63; krow = MP + b * 192 + 128 + t; fo = os + (size_t)(b * WIN + 64 + t) * 256; }
#pragma unroll
                    for (int bj = 0; bj < 2; ++bj) { const f32x4 v0 = acc[ai][bj][m][0], v1 = acc[ai][bj][m][1];
                        *(u32x4*)(KV + (size_t)krow * 256 + cl + bj * HALF) = pack8(v0, v1);
                        if (fo) { *(f32x4*)(fo + cl + bj * HALF) = v0; *(f32x4*)(fo + cl + bj * HALF + 4) = v1; } }
                    asm volatile("" ::: "memory"); }
        }
    }
};
struct EpiFoxIn {
    static constexpr bool PERM = true, PAIRED = false;
    bf16_t* Q; bf16_t* Kb; bf16_t* Vb; float* outK; float* outV;
    __device__ __forceinline__ void small(int row, int col, const f32x4 v0, const f32x4 v1) const {
        if (col < D) { *(u32x4*)(Q + (size_t)row * D + col) = pack8(v0 * C2, v1 * C2); return; }
        const bool isK = col < 2 * D; const int c = col & (D - 1); const int krow = row + (((row - MP) >> 6) + 1) * PAST;
        *(u32x4*)((isK ? Kb : Vb) + (size_t)krow * D + c) = pack8(v0, v1);
        float* fo = (isK ? outK : outV) + (size_t)row * D + c; *(f32x4*)fo = v0; *(f32x4*)(fo + 4) = v1;
    }
    __device__ __forceinline__ void operator()(const f32x4 (&acc)[2][2][4][2], const Unit& u, int wr, int wc, int fr, int fq) const {
        asm volatile("" : "+v"(fr), "+v"(fq));
        const int row0 = u.pm * BM + wr * 64 + fr; const int cl = (u.pn & 3) * BM + wc * 32 + 8 * fq;
        if (u.pn < 4) {
#pragma unroll
            for (int ai = 0; ai < 2; ++ai)
#pragma unroll
                for (int m = 0; m < 4; ++m) { bf16_t* qr = Q + (size_t)(row0 + ai * HALF + m * 16) * D + cl;
#pragma unroll
                    for (int bj = 0; bj < 2; ++bj) *(u32x4*)(qr + bj * HALF) = pack8(acc[ai][bj][m][0] * C2, acc[ai][bj][m][1] * C2);
                    asm volatile("" ::: "memory"); }
        } else {
            bf16_t* KV = (u.pn < 8) ? Kb : Vb; float* of = (u.pn < 8) ? outK : outV;
#pragma unroll
            for (int ai = 0; ai < 2; ++ai)
#pragma unroll
                for (int m = 0; m < 4; ++m) { const int row = row0 + ai * HALF + m * 16;
                    const int krow = (u.pm < MP / BM) ? row : row + (((row - MP) >> 6) + 1) * PAST;
#pragma unroll
                    for (int bj = 0; bj < 2; ++bj) { const f32x4 v0 = acc[ai][bj][m][0], v1 = acc[ai][bj][m][1];
                        *(u32x4*)(KV + (size_t)krow * D + cl + bj * HALF) = pack8(v0, v1);
                        float* fo = of + (size_t)row * D + cl + bj * HALF; *(f32x4*)fo = v0; *(f32x4*)(fo + 4) = v1; }
                    asm volatile("" ::: "memory"); }
        }
    }
};

template <class Epi>
__device__ __forceinline__ void sgemm_phase(LAS unsigned char* lds, const bf16_t* A, int lda, const bf16_t* Bt, int K_, int N, int row_base, int first, int stride, const Epi& E) {
    int tid = threadIdx.x; asm volatile("" : "+v"(tid));
    int K = K_; asm volatile("" : "+s"(K));
    const int wid = __builtin_amdgcn_readfirstlane(tid >> 6), lane = tid & 63, fr = lane & 15, fq = lane >> 4;
    constexpr int NRT = MS / 64; const int nitems = NRT * (N / 64), nks = K / 64;
    constexpr int SLOT = 64 * 68 * 4;
    for (int it = first; it < nitems; it += stride) {
        const int rt = it % NRT, ct = it / NRT;
        int brow0, bstr2, acol0;
        if (Epi::PAIRED) { const int nb = ct >> 3, cl = (ct & 7) * 32; brow0 = nb * 512 + (cl >> 7) * 256 + (cl & 127); bstr2 = 128; acol0 = nb * 256; }
        else { brow0 = ct * 64; bstr2 = 32; acol0 = 0; }
        const bf16_t* Ap = A + (size_t)(rt * 64 + fr) * lda + acol0 + 16 * fq;
        const bf16_t* Bp = Bt + (size_t)(brow0 + fr) * K + 16 * fq;
        f32x4 acc[4][4];
#pragma unroll
        for (int m = 0; m < 4; ++m)
#pragma unroll
            for (int n = 0; n < 4; ++n) acc[m][n] = (f32x4){0.f, 0.f, 0.f, 0.f};
        bf16x8 a0[4][2], b0[4][2], a1[4][2], b1[4][2];
#define SG_LOAD(a, b, ks) do { _Pragma("unroll") for (int m = 0; m < 4; ++m) { const bf16_t* p = Ap + (size_t)(16 * m) * lda + (ks) * 64; a[m][0] = *(const bf16x8*)p; a[m][1] = *(const bf16x8*)(p + 8); } \
                               _Pragma("unroll") for (int n = 0; n < 4; ++n) { const bf16_t* p = Bp + (size_t)((n & 1) * 16 + (n >> 1) * bstr2) * K + (ks) * 64; b[n][0] = *(const bf16x8*)p; b[n][1] = *(const bf16x8*)(p + 8); } } while (0)
#define SG_MMA(a, b) do { _Pragma("unroll") for (int m = 0; m < 4; ++m) _Pragma("unroll") for (int n = 0; n < 4; ++n) _Pragma("unroll") for (int h = 0; h < 2; ++h) \
                               acc[m][n] = __builtin_amdgcn_mfma_f32_16x16x32_bf16(b[n][h], a[m][h], acc[m][n], 0, 0, 0); } while (0)
        int ks = wid;
        if (ks < nks) SG_LOAD(a0, b0, ks);
        while (ks < nks) {
            if (ks + 8 < nks) SG_LOAD(a1, b1, ks + 8);
            SG_MMA(a0, b0);
            ks += 8; if (ks >= nks) break;
            if (ks + 8 < nks) SG_LOAD(a0, b0, ks + 8);
            SG_MMA(a1, b1);
            ks += 8;
        }
#undef SG_LOAD
#undef SG_MMA
        LAS float* myslot = (LAS float*)(lds + (wid & 3) * SLOT);
        if (wid >= 4) {
#pragma unroll
            for (int m = 0; m < 4; ++m)
#pragma unroll
                for (int n = 0; n < 4; ++n) *(LAS f32x4*)(myslot + (16 * m + fr) * 68 + 16 * n + 4 * fq) = acc[m][n];
        }
        __syncthreads();
        if (wid < 4) {
#pragma unroll
            for (int m = 0; m < 4; ++m)
#pragma unroll
                for (int n = 0; n < 4; ++n) acc[m][n] += *(const LAS f32x4*)(myslot + (16 * m + fr) * 68 + 16 * n + 4 * fq);
        }
        __syncthreads();
        if (wid < 4) {
#pragma unroll
            for (int m = 0; m < 4; ++m)
#pragma unroll
                for (int n = 0; n < 4; ++n) *(LAS f32x4*)(myslot + (16 * m + fr) * 68 + 16 * n + 4 * fq) = acc[m][n];
        }
        __syncthreads();
        {
            const int row = tid >> 3, cg = tid & 7; const int c0 = Epi::PAIRED ? 4 * cg : 8 * cg, c1 = c0 + (Epi::PAIRED ? 32 : 4);
            f32x4 v0 = (f32x4){0.f, 0.f, 0.f, 0.f}, v1 = v0;
#pragma unroll
            for (int s = 0; s < 4; ++s) { const LAS float* sl = (const LAS float*)(lds + s * SLOT) + row * 68; v0 += *(const LAS f32x4*)(sl + c0); v1 += *(const LAS f32x4*)(sl + c1); }
            const int grow = row_base + rt * 64 + row;
            if (Epi::PAIRED) E.small(grow, (ct >> 3) * 256 + (ct & 7) * 32 + c0, v0, v1); else E.small(grow, ct * 64 + c0, v0, v1);
        }
        __syncthreads();
    }
}
}

namespace att {
constexpr int SLOTB = 8192, NSLOT = 3;
constexpr int L_K = 0, L_V = NSLOT * SLOTB, L_WS = 2 * NSLOT * SLOTB, L_OST = L_WS + 8 * 256, L_AUX = L_OST + 8 * 4096;
constexpr int AUX_BYTES = 17408;
static_assert(L_AUX + AUX_BYTES <= 131072, "attention LDS");
typedef LAS const char* lcp;
__device__ __forceinline__ int crow(int r, int hi) { return (r & 3) + 8 * (r >> 2) + 4 * hi; }
__device__ __forceinline__ void glds16(const void* gsrc, unsigned lds_dst) { unsigned keep;
    asm volatile("s_mov_b32 %0, m0\n\ts_mov_b32 m0, %2\n\ts_nop 0\n\tglobal_load_lds_dwordx4 %1, off\n\ts_mov_b32 m0, %0" : "=&s"(keep) : "v"(gsrc), "s"(lds_dst) : "memory"); }
#define ATT_WAIT_BAR(N) asm volatile("s_waitcnt vmcnt(" #N ") lgkmcnt(0)\n\ts_barrier" ::: "memory")
typedef short v4i16_t __attribute__((ext_vector_type(4)));
__device__ __forceinline__ s16x4 vtr(lcp p) { return __builtin_bit_cast(s16x4, __builtin_amdgcn_ds_read_tr16_b64_v4i16((LAS v4i16_t*)p)); }

template <int MODE>
__device__ __forceinline__ void attn_unit(LAS unsigned char* shm, const bf16_t* Qw, bf16_t* Ow, int qpitch, const bf16_t* Kb, const bf16_t* Vb, int kvpitch,
                                          int t0, int t1, bool active, int qpos0w  ,
                                          const float* aux_src, int aux_n, float m_init, int tbl_off  ) {
    int tid = threadIdx.x; asm volatile("" : "+v"(tid));
    const int lane = tid & 63, r32 = lane & 31, hi = lane >> 5; const int wid = __builtin_amdgcn_readfirstlane(tid >> 6);
    const unsigned lds0 = (unsigned)(uintptr_t)shm;
    LAS float* wsf = (LAS float*)(shm + L_WS) + wid * 64;
    LAS float* aux = (LAS float*)(shm + L_AUX);
    if (MODE == 0) { for (int i = tid; i < aux_n; i += 512) aux[i] = aux_src[i]; }
    const bf16_t* ksrc = Kb + (size_t)lane * kvpitch + wid * 8;
    const bf16_t* vsrc = Vb + (size_t)(16 * (wid & 3) + (lane >> 2)) * kvpitch + (wid >> 2) * 32 + (lane & 3) * 8;
    const unsigned kdst = lds0 + L_K + wid * 1024, vdst = lds0 + L_V + wid * 1024;
#define DMA_KV(t, slot) do { glds16(ksrc + (size_t)(t) * 64 * kvpitch, (unsigned)__builtin_amdgcn_readfirstlane(kdst + (slot) * SLOTB)); \
                             glds16(vsrc + (size_t)(t) * 64 * kvpitch, (unsigned)__builtin_amdgcn_readfirstlane(vdst + (slot) * SLOTB)); } while (0)
    DMA_KV(t0, 0);
    bf16x8 qr[4];
    if (active) {
#pragma unroll
        for (int d0 = 0; d0 < 4; ++d0) qr[d0] = *(const bf16x8*)(Qw + (size_t)r32 * qpitch + d0 * 16 + hi * 8);
    } else {
#pragma unroll
        for (int d0 = 0; d0 < 4; ++d0) qr[d0] = (bf16x8){0, 0, 0, 0, 0, 0, 0, 0};
    }
    float mhat = m_init, l_reg = (MODE == 1 && hi == 0) ? 1.0f : 0.0f;
    f32x16 o[2]; o[0] = (f32x16){}; o[1] = (f32x16){};
    const int qpos = qpos0w + r32;
    const lcp kp0 = (lcp)shm + L_K + hi * 1024 + r32 * 16;
    const lcp vp0 = (lcp)shm + L_V + ((lane >> 4) & 1) * 32 + (lane & 3) * 8 + (4 * hi + ((lane & 15) >> 2)) * 64;
    int slot = 0;
    for (int t = t0; t < t1; ++t) {
        const int nslot = (slot == NSLOT - 1) ? 0 : slot + 1;
        if (t + 1 < t1) { DMA_KV(t + 1, nslot); ATT_WAIT_BAR(2); } else { ATT_WAIT_BAR(0); }
        const bool need = active && (MODE == 1 || 64 * t <= qpos0w + 31);
        if (need) {
            const lcp kp = kp0 + slot * SLOTB; const lcp vp = vp0 + slot * SLOTB;
            f32x16 p0, p1;
            if (MODE == 0) {
                const LAS f32x4* cb = (const LAS f32x4*)(aux + 64 * t + 4 * hi);
#pragma unroll
                for (int g = 0; g < 4; ++g) { const f32x4 a = cb[2 * g], b = cb[2 * g + 8];
#pragma unroll
                    for (int e = 0; e < 4; ++e) { p0[4 * g + e] = -a[e]; p1[4 * g + e] = -b[e]; } }
            } else {
                const LAS float* tb = (const LAS float*)((lcp)shm + L_AUX + tbl_off) + (64 * t + 63 - qpos);
#pragma unroll
                for (int r = 0; r < 16; ++r) { p0[r] = tb[crow(r, hi)]; p1[r] = tb[crow(r, hi) + 32]; }
            }
#pragma unroll
            for (int d0 = 0; d0 < 4; ++d0) {
                const bf16x8 b0 = *(const LAS bf16x8*)(kp + d0 * 2048);
                const bf16x8 b1 = *(const LAS bf16x8*)(kp + d0 * 2048 + 512);
                p0 = __builtin_amdgcn_mfma_f32_32x32x16_bf16(b0, qr[d0], p0, 0, 0, 0);
                p1 = __builtin_amdgcn_mfma_f32_32x32x16_bf16(b1, qr[d0], p1, 0, 0, 0);
            }
            if (MODE == 0 && 64 * t + 63 > qpos0w) {
                const int kb = 64 * t + 4 * hi;
#pragma unroll
                for (int r = 0; r < 16; ++r) { const int kv = kb + (r & 3) + 8 * (r >> 2); if (kv > qpos) p0[r] = -INFINITY; if (kv + 32 > qpos) p1[r] = -INFINITY; }
            }
            float rm = fmaxf(p0[0], p1[0]);
#pragma unroll
            for (int r = 1; r < 16; ++r) rm = fmaxf(rm, fmaxf(p0[r], p1[r]));
            { auto rr = __builtin_amdgcn_permlane32_swap(__float_as_uint(rm), __float_as_uint(rm), false, false); rm = fmaxf(__uint_as_float(rr[0]), __uint_as_float(rr[1])); }
            const float mnew = fmaxf(mhat, rm);
            const float f = __builtin_amdgcn_exp2f(mhat - mnew);
            float sacc = 0.f;
#pragma unroll
            for (int r = 0; r < 16; ++r) { p0[r] = __builtin_amdgcn_exp2f(p0[r] - mnew); p1[r] = __builtin_amdgcn_exp2f(p1[r] - mnew); sacc += p0[r] + p1[r]; }
            l_reg = l_reg * f + sacc;
            if (__any(mnew > mhat)) {
                if (hi == 0) wsf[r32] = f;
#pragma unroll
                for (int d_ = 0; d_ < 2; ++d_)
#pragma unroll
                    for (int r = 0; r < 16; ++r) o[d_][r] *= wsf[crow(r, hi)];
            }
            mhat = mnew;
            bf16x8 pa[4];
            { u32x4 w;
              w = (u32x4){pg8::cvt_pk_bf16(p0[0], p0[1]), pg8::cvt_pk_bf16(p0[2], p0[3]), pg8::cvt_pk_bf16(p0[4], p0[5]), pg8::cvt_pk_bf16(p0[6], p0[7])}; pa[0] = __builtin_bit_cast(bf16x8, w);
              w = (u32x4){pg8::cvt_pk_bf16(p0[8], p0[9]), pg8::cvt_pk_bf16(p0[10], p0[11]), pg8::cvt_pk_bf16(p0[12], p0[13]), pg8::cvt_pk_bf16(p0[14], p0[15])}; pa[1] = __builtin_bit_cast(bf16x8, w);
              w = (u32x4){pg8::cvt_pk_bf16(p1[0], p1[1]), pg8::cvt_pk_bf16(p1[2], p1[3]), pg8::cvt_pk_bf16(p1[4], p1[5]), pg8::cvt_pk_bf16(p1[6], p1[7])}; pa[2] = __builtin_bit_cast(bf16x8, w);
              w = (u32x4){pg8::cvt_pk_bf16(p1[8], p1[9]), pg8::cvt_pk_bf16(p1[10], p1[11]), pg8::cvt_pk_bf16(p1[12], p1[13]), pg8::cvt_pk_bf16(p1[14], p1[15])}; pa[3] = __builtin_bit_cast(bf16x8, w); }
#pragma unroll
            for (int d0 = 0; d0 < 2; ++d0)
#pragma unroll
                for (int ks = 0; ks < 4; ++ks) {
                    const s16x4 lo = vtr(vp + d0 * 4096 + ks * 1024), hh = vtr(vp + d0 * 4096 + ks * 1024 + 512);
                    const bf16x8 vf = (bf16x8){lo[0], lo[1], lo[2], lo[3], hh[0], hh[1], hh[2], hh[3]};
                    o[d0] = __builtin_amdgcn_mfma_f32_32x32x16_bf16(pa[ks], vf, o[d0], 0, 0, 0);
                }
        }
        slot = nslot;
    }
    if (active) {
        { auto rr = __builtin_amdgcn_permlane32_swap(__float_as_uint(l_reg), __float_as_uint(l_reg), false, false); l_reg = __uint_as_float(rr[0]) + __uint_as_float(rr[1]); }
        if (hi == 0) wsf[32 + r32] = l_reg;
        float rli[16];
#pragma unroll
        for (int r = 0; r < 16; ++r) rli[r] = __builtin_amdgcn_rcpf(wsf[32 + crow(r, hi)]);
        LAS bf16_t* stg = (LAS bf16_t*)(shm + L_OST) + wid * 2048;
#pragma unroll
        for (int r = 0; r < 16; ++r) { const int orow = crow(r, hi);
#pragma unroll
            for (int d0 = 0; d0 < 2; ++d0) { const float v = o[d0][r] * rli[r]; stg[orow * 64 + d0 * 32 + r32] = (bf16_t)(pg8::cvt_pk_bf16(v, v) & 0xffffu); } }
#pragma unroll
        for (int i = 0; i < 4; ++i) { const int row = i * 8 + (lane >> 3), ch = lane & 7; const u32x4 v = *(const LAS u32x4*)(stg + row * 64 + ch * 8); *(u32x4*)(Ow + (size_t)row * qpitch + ch * 8) = v; }
    }
    asm volatile("s_waitcnt lgkmcnt(0)\n\ts_barrier" ::: "memory");
#undef DMA_KV
}
#undef ATT_WAIT_BAR
}

#define XB_TMO      128
#define XB_XCNT(j)  (256  + 64 * (j))
#define XB_XSUB(j)  (1280 + 64 * (j))
#define XB_XGEN(j)  (2304 + 64 * (j))
#define XB_TOP      3328
#define XB_TOPGEN   3392
#define XCD_BAR_WORDS 3456
#define XB_SPIN_CAP (1u << 18)
__device__ __forceinline__ unsigned xb_ld(unsigned* p)              { return __hip_atomic_load(p, __ATOMIC_RELAXED, __HIP_MEMORY_SCOPE_AGENT); }
__device__ __forceinline__ unsigned xb_add(unsigned* p, unsigned v) { return __hip_atomic_fetch_add(p, v, __ATOMIC_RELAXED, __HIP_MEMORY_SCOPE_AGENT); }
__device__ __forceinline__ unsigned xb_xcc_id() { return (unsigned)__builtin_amdgcn_s_getreg((3 << 11) | 20) & 0xFu; }
#define XB_SPIN(cond, bar) do { unsigned _sp = 0; while (cond) { __builtin_amdgcn_s_sleep(1); \
    if ((++_sp & 255u) == 0u) { if (xb_ld(&(bar)[XB_TMO])) break; if (_sp > XB_SPIN_CAP) { atomicAdd(&(bar)[XB_TMO], 1u); break; } } } } while (0)
struct XcdBarrier { unsigned* bar; unsigned x; volatile LAS unsigned* st; };
__device__ __forceinline__ XcdBarrier xcd_barrier_post(unsigned* bar, volatile LAS unsigned* st) {
    XcdBarrier b; b.bar = bar; b.x = xb_xcc_id(); b.st = st;
    if (threadIdx.x == 0) (void)xb_add(&bar[XB_XCNT(b.x)], 1u);
    return b;
}
__device__ __forceinline__ void xcd_barrier_complete(unsigned* bar, unsigned x, unsigned& nloc, unsigned& nx) {
    const unsigned G = gridDim.x * gridDim.y * gridDim.z;
    unsigned sum, cnt, mine, sp = 0u;
    for (;;) {
        sum = 0u; cnt = 0u; mine = 0u;
#pragma unroll
        for (unsigned j = 0; j < 16; ++j) { const unsigned c = xb_ld(&bar[XB_XCNT(j)]); sum += c; cnt += (c > 0u) ? 1u : 0u; mine = (j == x) ? c : mine; }
        if (sum == G) break;
        __builtin_amdgcn_s_sleep(1);
        if ((++sp & 255u) == 0u) { if (xb_ld(&bar[XB_TMO])) break; if (sp > XB_SPIN_CAP) { atomicAdd(&bar[XB_TMO], 1u); break; } }
    }
    nloc = mine > 0u ? mine : 1u; nx = cnt > 0u ? cnt : 1u;
}
__device__ __forceinline__ void xcd_barrier(const XcdBarrier& b) {
    asm volatile("s_waitcnt vmcnt(0)" ::: "memory");
    __syncthreads();
    if (threadIdx.x == 0) {
        unsigned* bar = b.bar;
        __builtin_amdgcn_s_waitcnt(0);
        unsigned nloc = b.st[0], nx = b.st[1];
        if (nloc == 0u) { xcd_barrier_complete(bar, b.x, nloc, nx); b.st[0] = nloc; b.st[1] = nx; }
        const unsigned old = xb_add(&bar[XB_XSUB(b.x)], 1u);
        const unsigned gen = old / nloc;
        if (old + 1u == (gen + 1u) * nloc) {
            __builtin_amdgcn_fence(__ATOMIC_RELEASE, "agent");
            asm volatile("s_waitcnt vmcnt(0)" ::: "memory");
            const unsigned og = xb_add(&bar[XB_TOP], 1u);
            const unsigned tg = og / nx;
            if (og + 1u == (tg + 1u) * nx) xb_add(&bar[XB_TOPGEN], 1u);
            else XB_SPIN(xb_ld(&bar[XB_TOPGEN]) == tg, bar);
            __builtin_amdgcn_fence(__ATOMIC_ACQUIRE, "agent");
            xb_add(&bar[XB_XGEN(b.x)], 1u);
            asm volatile("s_waitcnt vmcnt(0)" ::: "memory");
        } else {
            XB_SPIN(xb_ld(&bar[XB_XGEN(b.x)]) == gen, bar);
            __builtin_amdgcn_fence(__ATOMIC_ACQUIRE, "agent");
            asm volatile("s_waitcnt vmcnt(0)" ::: "memory");
        }
    }
    __syncthreads();
}

#define LDS_WAIT() asm volatile("s_waitcnt lgkmcnt(0)" ::: "memory")
__device__ __forceinline__ unsigned f2bf(float f) { unsigned u = __builtin_bit_cast(unsigned, f); return (u + 0x7fffu + ((u >> 16) & 1u)) >> 16; }
__device__ __forceinline__ unsigned pk2(float lo, float hi) { return pg8::cvt_pk_bf16(lo, hi); }
__device__ __forceinline__ float wave_sum(float v) {
#pragma unroll
    for (int o = 1; o < 64; o <<= 1) v += __shfl_xor(v, o);
    return v;
}
__device__ __forceinline__ void transpose_item(const float* W, int ldw, int K, bf16_t* WT, int dest_row, int k0, int n0, LAS float* scr, int lane) {
#pragma unroll 8
    for (int i = 0; i < 32; ++i) { const int kk = 2 * i + (lane >> 5); scr[kk * 33 + (lane & 31)] = W[(size_t)(k0 + kk) * ldw + n0 + (lane & 31)]; }
    LDS_WAIT(); asm volatile("" ::: "memory");
    const int c = lane & 7;
#pragma unroll
    for (int j = 0; j < 4; ++j) { const int n = (lane >> 3) + 8 * j; const LAS float* s = scr + (8 * c) * 33 + n;
        u32x4 o; o.x = pk2(s[0 * 33], s[1 * 33]); o.y = pk2(s[2 * 33], s[3 * 33]); o.z = pk2(s[4 * 33], s[5 * 33]); o.w = pk2(s[6 * 33], s[7 * 33]);
        *(u32x4*)(WT + (size_t)(dest_row + n) * K + k0 + 8 * c) = o; }
    LDS_WAIT(); asm volatile("" ::: "memory");
}
template <bool GATE>
__device__ __forceinline__ bool transpose_family(int& r, const float* W, int ldw, size_t sstride, int K, int N, int cnt, bf16_t* WT, LAS float* scr, int lane) {
    const int per = (K / 64) * (N / 32);
    if (r >= per * cnt) { r -= per * cnt; return false; }
    const int mi = r / per, it = r % per, nblk = N / 32, kb = it / nblk, nb = it % nblk, n0 = 32 * nb;
    int dest = n0;
    if (GATE) { const int ch = n0 & 255; dest = (ch >> 7) * 256 + ((n0 >> 8) ? 128 : 0) + (ch & 127); }
    transpose_item(W + (size_t)mi * sstride, ldw, K, WT + (size_t)mi * N * K, dest, 64 * kb, n0, scr, lane);
    return true;
}
__device__ __forceinline__ void ln_row(f32x4 (&v)[4], const float* g, const float* b, int lane) {
    float s = 0.f;
#pragma unroll
    for (int j = 0; j < 4; ++j) s += (v[j].x + v[j].y) + (v[j].z + v[j].w);
    const float mean = wave_sum(s) * (1.f / D); float s2 = 0.f;
#pragma unroll
    for (int j = 0; j < 4; ++j) { v[j] = v[j] - mean; s2 += (v[j].x * v[j].x + v[j].y * v[j].y) + (v[j].z * v[j].z + v[j].w * v[j].w); }
    const float rstd = 1.f / sqrtf(wave_sum(s2) * (1.f / D) + LN_EPS);
#pragma unroll
    for (int j = 0; j < 4; ++j) { const f32x4 gg = *(const f32x4*)(g + 4 * lane + 256 * j), bb = *(const f32x4*)(b + 4 * lane + 256 * j); v[j] = v[j] * rstd * gg + bb; }
}
__device__ __forceinline__ void store_row_bf16(bf16_t* orow, const f32x4 (&v)[4], int lane) {
    u32x2* o8 = (u32x2*)orow + lane;
#pragma unroll
    for (int j = 0; j < 4; ++j) { u32x2 w; w.x = pk2(v[j].x, v[j].y); w.y = pk2(v[j].z, v[j].w); o8[64 * j] = w; }
}

constexpr int RING_BYTES = 131072, LDSCTL_OFF = RING_BYTES, MISC_OFF = LDSCTL_OFF + 320, LDS_BYTES = 147456;
constexpr int NPH = 36;
struct Args { const float* in[27]; float* out; unsigned char* ws; int ph_lo, ph_hi; };
enum { I_XP = 0, I_XS, I_RGCONV, I_RGH, I_CSWAK, I_CSWAV, I_CFOXK, I_CFOXV, I_CFOXF, I_LNG, I_LNB, I_WUP, I_WDOWN, I_RGWIN, I_RGCONVW, I_RGCONVB, I_RGGATEW, I_RGGATEB,
       I_RGLAM, I_RGWOUT, I_SWAQKV, I_SWASINK, I_SWAWOUT, I_RELTAB, I_FOXWIN, I_FOXBF, I_FOXWOUT };

__global__ void __launch_bounds__(512, 2) fwd_megakernel(Args args) {
    extern __shared__ __attribute__((aligned(16))) unsigned char lds_raw[];
    LAS unsigned char* lds = (LAS unsigned char*)lds_raw;
    volatile LAS unsigned* MISC = (volatile LAS unsigned*)(lds + MISC_OFF);
    const int G = gridDim.x, NGW = G * 8;
    unsigned* ctl = (unsigned*)(args.ws + WS_CTL);
    for (int u = threadIdx.x; u < (LDS_BYTES - LDSCTL_OFF) / 4; u += 512) ((LAS unsigned*)(lds + LDSCTL_OFF))[u] = 0u;
    __syncthreads();
    XcdBarrier bar; bar.bar = ctl + CW_BAR; bar.x = 0; bar.st = nullptr;
    if (!MK_PER_PHASE) bar = xcd_barrier_post(ctl + CW_BAR, MISC + 8);
    const int lo = args.ph_lo, hi = args.ph_hi;

#define WUP ((bf16_t*)(args.ws + WS_WUP))
#define WDOWN ((bf16_t*)(args.ws + WS_WDOWN))
#define WRGIN ((bf16_t*)(args.ws + WS_WRGIN))
#define WRGGATE ((bf16_t*)(args.ws + WS_WRGGATE))
#define WRGOUT ((bf16_t*)(args.ws + WS_WRGOUT))
#define WSWAQKV ((bf16_t*)(args.ws + WS_WSWAQKV))
#define WSWAOUT ((bf16_t*)(args.ws + WS_WSWAOUT))
#define WFOXIN ((bf16_t*)(args.ws + WS_WFOXIN))
#define WFOXOUT ((bf16_t*)(args.ws + WS_WFOXOUT))
#define XN ((bf16_t*)(args.ws + WS_XN))
#define X (args.out + O_Y)
#define CHA ((float*)(args.ws + WS_CHA))
#define CHB ((float*)(args.ws + WS_CHB))
#define LOGF ((float*)(args.ws + WS_LOGF))
#define SP8 ((float*)(args.ws + WS_SP8))
#define CK2P ((float*)(args.ws + WS_CK2P))
#define CK2S ((float*)(args.ws + WS_CK2S))
#define KSW ((bf16_t*)(args.ws + WS_KSW))
#define VSW ((bf16_t*)(args.ws + WS_VSW))
#define HB ((bf16_t*)(args.ws + WS_H))
#define GB ((bf16_t*)(args.ws + WS_G))
#define UB ((float*)(args.ws + WS_U))
#define AB ((float*)(args.ws + WS_U))
#define CONVB ((bf16_t*)(args.ws + WS_CONV))
#define HG ((bf16_t*)(args.ws + WS_CONV))
#define BB ((float*)(args.ws + WS_B))
#define QB ((bf16_t*)(args.ws + WS_Q))
#define OB ((bf16_t*)(args.ws + WS_O))
#define KF ((bf16_t*)(args.ws + WS_KF))
#define VF ((bf16_t*)(args.ws + WS_VF))
#define OUT (args.out)
    int ph = 0;
#define PH_BEGIN if (ph >= lo && ph < hi) { int bx = blockIdx.x; asm volatile("" : "+s"(bx)); int tid = threadIdx.x; asm volatile("" : "+v"(tid)); const int lane = tid & 63; const int wave = __builtin_amdgcn_readfirstlane(tid >> 6); const int vcu = (G % 8 == 0) ? (bx % 8) * (G / 8) + bx / 8 : bx; const int gw = vcu * 8 + wave; (void)gw; (void)lane;
#define PH_END   if (ph + 1 < hi) { xcd_barrier(bar); for (int xb_ = 0; xb_ < XBAR; ++xb_) xcd_barrier(bar); } } ++ph;

    PH_BEGIN for (int rep_ = 0; rep_ < NREP(0); ++rep_, (rep_ < NREP(0) ? xcd_barrier(bar) : (void)0)) if (EN(0))
    {
        LAS float* scr = (LAS float*)(lds + wave * 16384);
        constexpr int NITEMS = (45 * 1024 * 1024 + 512 * 1024) / 2048;
        for (int it = gw; it < NITEMS; it += NGW) {
            int r = it;
            if (transpose_family<false>(r, args.in[I_WUP], FF, (size_t)D * FF, D, FF, 4, WUP, scr, lane)) continue;
            if (transpose_family<false>(r, args.in[I_WDOWN], D, (size_t)D * FF, FF, D, 4, WDOWN, scr, lane)) continue;
            if (transpose_family<false>(r, args.in[I_RGWIN], 2 * D, (size_t)D * 2 * D, D, 2 * D, 2, WRGIN, scr, lane)) continue;
            if (transpose_family<true>(r, args.in[I_RGGATEW], 512, (size_t)256 * 512, 256, 512, 8, WRGGATE, scr, lane)) continue;
            if (transpose_family<false>(r, args.in[I_RGWOUT], D, (size_t)D * D, D, D, 2, WRGOUT, scr, lane)) continue;
            if (transpose_family<false>(r, args.in[I_SWAQKV], 1536, 0, D, 1536, 1, WSWAQKV, scr, lane)) continue;
            if (transpose_family<false>(r, args.in[I_SWAWOUT], D, 0, D, D, 1, WSWAOUT, scr, lane)) continue;
            if (transpose_family<false>(r, args.in[I_FOXWIN], 3088, 0, D, 3072, 1, WFOXIN, scr, lane)) continue;
            transpose_family<false>(r, args.in[I_FOXWOUT], D, 0, D, D, 1, WFOXOUT, scr, lane);
        }
        for (int m = gw; m < M; m += NGW) {
            const float* xr = (m < MP) ? args.in[I_XP] + (size_t)m * D : args.in[I_XS] + (size_t)(m - MP) * D;
            f32x4 v[4];
#pragma unroll
            for (int j = 0; j < 4; ++j) v[j] = *(const f32x4*)(xr + 4 * lane + 256 * j);
#pragma unroll
            for (int j = 0; j < 4; ++j) *(f32x4*)(X + (size_t)m * D + 4 * lane + 256 * j) = v[j];
            store_row_bf16(XN + (size_t)m * D, v, lane);
        }
        for (int i = gw * 64 + lane; i < 2 * BS * WIN * 64; i += NGW * 64) {
            const int which = i / (BS * WIN * 64), e = i % (BS * WIN * 64), b = e / (WIN * 64), r = (e / 64) % WIN, c = (e % 64) * 4;
            const float* src = args.in[which ? I_CSWAV : I_CSWAK] + (size_t)e * 4;
            const f32x4 v = *(const f32x4*)src;
            bf16_t* dst = (which ? VSW : KSW) + (size_t)(MP + b * 192 + r) * 256 + c;
            u32x2 w; w.x = pk2(v.x, v.y); w.y = pk2(v.z, v.w); *(u32x2*)dst = w;
            if (r >= 64) *(f32x4*)(OUT + (which ? O_SWAV_S : O_SWAK_S) + (size_t)(b * WIN + r - 64) * 256 + c) = v;
        }
    }
    PH_END

#pragma nounroll
    for (int layer = 0; layer < DEPTH; ++layer) {
        const int kind = layer % 3, j = layer / 3;
#pragma nounroll
        for (int half = 0; half < 2; ++half) {
            const bf16_t* resA; const bf16_t* resW; int resK;
            if (half == 0) {
                if (kind == 0) {
                    PH_BEGIN for (int rep_ = 0; rep_ < NREP(1); ++rep_, (rep_ < NREP(1) ? xcd_barrier(bar) : (void)0)) if (EN(1))
                    { pg8::Gemm g{XN, WRGIN + (size_t)j * 2 * D * D, MP, 2 * D, D, D, 1 << 20, 0}; pg8::StaticOrder S; S.init(MP, 2 * D, G, bx);
                      pg8::EpiRgIn E{GB, UB}; pg8::gemm_phase<pg8::EpiRgIn, true>(lds, g, S, E);
                      pg8::sgemm_phase<pg8::EpiRgIn>(lds, XN + (size_t)MP * D, D, WRGIN + (size_t)j * 2 * D * D, D, 2 * D, MP, vcu, G, E); }
                    PH_END
                    PH_BEGIN for (int rep_ = 0; rep_ < NREP(2); ++rep_, (rep_ < NREP(2) ? xcd_barrier(bar) : (void)0)) if (EN(2))
                    {
                        const float* cw = args.in[I_RGCONVW] + (size_t)j * 4 * D; const float* cb = args.in[I_RGCONVB] + (size_t)j * D;
                        if (vcu == 0) for (int c = tid; c < D; c += 512) SP8[c] = 8.0f * log1pf(expf(-args.in[I_RGLAM][(size_t)j * D + c]));
                        for (int m = gw; m < M; m += NGW) {
                            int b, t, T; const float* st = nullptr; float* oc;
                            if (m < MP) { b = m >> 12; t = m & (TP - 1); T = TP; oc = OUT + O_RGCONV_P + (size_t)(j * BP + b) * 3 * D; }
                            else { const int rs = m - MP; b = rs >> 6; t = rs & 63; T = TS; st = args.in[I_RGCONV] + (size_t)(j * BS + b) * 3 * D; oc = OUT + O_RGCONV_S + (size_t)(j * BS + b) * 3 * D; }
#pragma unroll
                            for (int jj = 0; jj < 4; ++jj) { const int c = 4 * lane + 256 * jj;
                                f32x4 acc = *(const f32x4*)(cb + c); f32x4 ucur;
#pragma unroll
                                for (int k = 0; k < 4; ++k) { const int tt = t - 3 + k; f32x4 uv;
                                    if (tt >= 0) uv = *(const f32x4*)(UB + (size_t)(m - 3 + k) * D + c);
                                    else if (st) uv = *(const f32x4*)(st + (size_t)(tt + 3) * D + c);
                                    else uv = (f32x4){0.f, 0.f, 0.f, 0.f};
                                    acc += uv * *(const f32x4*)(cw + k * D + c); if (k == 3) ucur = uv; }
                                u32x2 w; w.x = pk2(acc.x, acc.y); w.y = pk2(acc.z, acc.w); *(u32x2*)(CONVB + (size_t)m * D + c) = w;
                                if (t >= T - 3) *(f32x4*)(oc + (size_t)(t - (T - 3)) * D + c) = ucur; }
                        }
                    }
                    PH_END
                    PH_BEGIN for (int rep_ = 0; rep_ < NREP(3); ++rep_, (rep_ < NREP(3) ? xcd_barrier(bar) : (void)0)) if (EN(3))
                    { pg8::Gemm g{CONVB, WRGGATE + (size_t)j * 2048 * 256, MP, 2048, 256, D, 2, 256}; pg8::StaticOrder S; S.init(MP, 2048, G, bx);
                      pg8::EpiGates E{args.in[I_RGGATEB] + (size_t)j * 2048, SP8, CONVB, AB, BB}; pg8::gemm_phase<pg8::EpiGates, true>(lds, g, S, E);
                      pg8::sgemm_phase<pg8::EpiGates>(lds, CONVB + (size_t)MP * D, D, WRGGATE + (size_t)j * 2048 * 256, 256, 2048, MP, vcu, G, E); }
                    PH_END
                    PH_BEGIN for (int rep_ = 0; rep_ < NREP(4); ++rep_, (rep_ < NREP(4) ? xcd_barrier(bar) : (void)0)) if (EN(4))
                    {
                        for (int it = bx; it < 272 * 2; it += G) { const int chunk = it >> 1, ch = (it & 1) * 512 + tid; const size_t base = (size_t)chunk * 64 * D + ch;
                            float P = 1.f, Sv = 0.f;
#pragma unroll 8
                            for (int t = 0; t < 64; ++t) { const float a = AB[base + (size_t)t * D], b = BB[base + (size_t)t * D]; Sv = a * Sv + b; P *= a; }
                            CHA[chunk * D + ch] = P; CHB[chunk * D + ch] = Sv; }
                    }
                    PH_END
                    PH_BEGIN for (int rep_ = 0; rep_ < NREP(5); ++rep_, (rep_ < NREP(5) ? xcd_barrier(bar) : (void)0)) if (EN(5))
                    {
                        for (int it = bx; it < 272 * 2; it += G) { const int chunk = it >> 1, ch = (it & 1) * 512 + tid; const size_t base = (size_t)chunk * 64 * D + ch;
                            float h; bool lastc; float* oh;
                            if (chunk < 256) { const int b = chunk >> 6, c = chunk & 63; h = 0.f;
                                for (int cc = 0; cc < c; ++cc) h = CHA[(b * 64 + cc) * D + ch] * h + CHB[(b * 64 + cc) * D + ch];
                                lastc = (c == 63); oh = OUT + O_RGH_P + (size_t)(j * BP + b) * D + ch; }
                            else { const int b = chunk - 256; h = args.in[I_RGH][(size_t)(j * BS + b) * D + ch]; lastc = true; oh = OUT + O_RGH_S + (size_t)(j * BS + b) * D + ch; }
#pragma unroll 8
                            for (int t = 0; t < 64; ++t) { const float a = AB[base + (size_t)t * D], b = BB[base + (size_t)t * D]; h = a * h + b;
                                const float gt = __uint_as_float((unsigned)GB[base + (size_t)t * D] << 16); HG[base + (size_t)t * D] = (bf16_t)f2bf(h * gt); }
                            if (lastc) *oh = h; }
                    }
                    PH_END
                    resA = HG; resW = WRGOUT + (size_t)j * D * D; resK = D;
                } else if (kind == 1) {
                    PH_BEGIN for (int rep_ = 0; rep_ < NREP(6); ++rep_, (rep_ < NREP(6) ? xcd_barrier(bar) : (void)0)) if (EN(6))
                    { pg8::Gemm g{XN, WSWAQKV, MP, 1536, D, D, 1 << 20, 0}; pg8::StaticOrder S; S.init(MP, 1536, G, bx);
                      pg8::EpiSwaQkv E{QB, KSW, VSW, OUT + O_SWAK_P, OUT + O_SWAK_S, OUT + O_SWAV_P, OUT + O_SWAV_S}; pg8::gemm_phase<pg8::EpiSwaQkv, true>(lds, g, S, E);
                      pg8::sgemm_phase<pg8::EpiSwaQkv>(lds, XN + (size_t)MP * D, D, WSWAQKV, D, 1536, MP, G - 1 - bx, G, E); }
                    PH_END
                    PH_BEGIN for (int rep_ = 0; rep_ < NREP(7); ++rep_, (rep_ < NREP(7) ? xcd_barrier(bar) : (void)0)) if (EN(7))
                    {
                        LAS float* tbl = (LAS float*)(lds + att::L_AUX);
                        for (int i = tid; i < 16 * 256; i += 512) { const int h = i >> 8, idx = i & 255; const int rel = idx - 191; const int n = rel < 0 ? -rel : rel;
                            int val; if (n < 8) val = n; else { val = 2 + (31 - __builtin_clz((unsigned)(n * n))); if (val > 15) val = 15; }
                            const int bucket = (rel > 0 ? 16 : 0) + val;
                            tbl[i] = (idx < 255) ? args.in[I_RELTAB][bucket * NH + h] * LOG2E : 0.f; }
                        __syncthreads();
                        for (int u = vcu; u < 1088; u += G) {
                            int m0, kr0, t0, kvh;
                            if (u < 1024) { const int b = u >> 8, c = (u >> 2) & 63; kvh = u & 3; m0 = b * TP + c * 64; kr0 = b * TP + (c - 2) * 64; t0 = c >= 2 ? 0 : 2 - c; }
                            else { const int us = u - 1024, b = us >> 2; kvh = us & 3; m0 = MP + b * 64; kr0 = MP + b * 192; t0 = 0; }
                            const int hd = kvh * 4 + (wave >> 1); const int mw = m0 + (wave & 1) * 32;
                            const float sink2 = args.in[I_SWASINK][hd] * LOG2E;
                            att::attn_unit<1>(lds, QB + (size_t)mw * D + hd * 64, OB + (size_t)mw * D + hd * 64, D, KSW + (ptrdiff_t)kr0 * 256 + kvh * 64, VSW + (ptrdiff_t)kr0 * 256 + kvh * 64, 256,
                                              t0, 3, true, (wave & 1) * 32, nullptr, 0, sink2, hd * 1024);
                        }
                    }
                    PH_END
                    resA = OB; resW = WSWAOUT; resK = D;
                } else {
                    PH_BEGIN for (int rep_ = 0; rep_ < NREP(8); ++rep_, (rep_ < NREP(8) ? xcd_barrier(bar) : (void)0)) if (EN(8))
                    { pg8::Gemm g{XN, WFOXIN, MP, 3072, D, D, 1 << 20, 0}; pg8::StaticOrder S; S.init(MP, 3072, G, bx);
                      pg8::EpiFoxIn E{QB, KF, VF, OUT + O_FOXK, OUT + O_FOXV}; pg8::gemm_phase<pg8::EpiFoxIn, true>(lds, g, S, E);
                      pg8::sgemm_phase<pg8::EpiFoxIn>(lds, XN + (size_t)MP * D, D, WFOXIN, D, 3072, MP, vcu, G, E); }
                    PH_END
                    PH_BEGIN for (int rep_ = 0; rep_ < NREP(9); ++rep_, (rep_ < NREP(9) ? xcd_barrier(bar) : (void)0)) if (EN(9))
                    {
                        for (int s = gw; s < 64 + 256; s += NGW) {
                            if (s < 64) { const int b = s >> 4, h = s & 15; const float* src = LOGF + ((size_t)b * TP + 64 * lane) * NH + h;
                                float sum = 0.f;
                                for (int i = 0; i < 64; ++i) sum += src[(size_t)i * NH];
                                float incl = sum;
#pragma unroll
                                for (int o = 1; o < 64; o <<= 1) { const float v = __shfl_up(incl, o); if (lane >= o) incl += v; }
                                float run = incl - sum; float* dst = CK2P + (size_t)s * TP + 64 * lane;
                                for (int i = 0; i < 64; ++i) { run += src[(size_t)i * NH]; dst[i] = run * LOG2E; } }
                            else { const int ss = s - 64, b = ss >> 4, h = ss & 15; const float* cf = args.in[I_CFOXF] + (size_t)b * PAST * NH + h; const float* nf = LOGF + (size_t)(MP + b * 64) * NH + h;
                                float sum = 0.f;
                                for (int i = 0; i < 17; ++i) { const int p = 17 * lane + i; sum += (p < PAST) ? cf[(size_t)p * NH] : nf[(size_t)(p - PAST) * NH]; }
                                float incl = sum;
#pragma unroll
                                for (int o = 1; o < 64; o <<= 1) { const float v = __shfl_up(incl, o); if (lane >= o) incl += v; }
                                float run = incl - sum; float* dst = CK2S + (size_t)ss * 1088 + 17 * lane;
                                for (int i = 0; i < 17; ++i) { const int p = 17 * lane + i; run += (p < PAST) ? cf[(size_t)p * NH] : nf[(size_t)(p - PAST) * NH]; dst[i] = run * LOG2E; } }
                        }
                    }
                    PH_END
                    PH_BEGIN for (int rep_ = 0; rep_ < NREP(10); ++rep_, (rep_ < NREP(10) ? xcd_barrier(bar) : (void)0)) if (EN(10))
                    {
                        for (int i = 0; ; ++i) {
                            const int u = i * G + vcu; if (u >= 1024 + 256) break;
                            if (u < 1024) { const int uu = u & 255, ii = u >> 8, bh = uu >> 2, s0 = 2 * (uu & 3); const int qb = (ii == 0) ? s0 : (ii == 1) ? 15 - s0 : (ii == 2) ? s0 + 1 : 14 - s0;
                                const int b = bh >> 4, h = bh & 15; const size_t mw = (size_t)b * TP + 256 * qb + 32 * wave;
                                att::attn_unit<0>(lds, QB + mw * D + h * 64, OB + mw * D + h * 64, D, KF + (size_t)b * TP * D + h * 64, VF + (size_t)b * TP * D + h * 64, D,
                                                  0, 4 * qb + 4, true, 256 * qb + 32 * wave, CK2P + (size_t)bh * TP, 256 * (qb + 1), -INFINITY, 0); }
                            else { const int us = u - 1024, b = us >> 4, h = us & 15; const size_t mw = (size_t)MP + b * 64 + 32 * (wave & 1);
                                att::attn_unit<0>(lds, QB + mw * D + h * 64, OB + mw * D + h * 64, D, KF + (size_t)(MP + b * 1088) * D + h * 64, VF + (size_t)(MP + b * 1088) * D + h * 64, D,
                                                  0, 17, wave < 2, PAST + 32 * wave, CK2S + (size_t)us * 1088, 1088, -INFINITY, 0); }
                        }
                    }
                    PH_END
                    resA = OB; resW = WFOXOUT; resK = D;
                }
            } else {
                PH_BEGIN for (int rep_ = 0; rep_ < NREP(11); ++rep_, (rep_ < NREP(11) ? xcd_barrier(bar) : (void)0)) if (EN(11))
                { pg8::Gemm g{XN, WUP + (size_t)layer * D * FF, MP, FF, D, D, 1 << 20, 0}; pg8::StaticOrder S; S.init(MP, FF, G, bx);
                  pg8::EpiSqRelu E{HB}; pg8::gemm_phase<pg8::EpiSqRelu, true>(lds, g, S, E);
                  pg8::sgemm_phase<pg8::EpiSqRelu>(lds, XN + (size_t)MP * D, D, WUP + (size_t)layer * D * FF, D, FF, MP, vcu, G, E); }
                PH_END
                resA = HB; resW = WDOWN + (size_t)layer * D * FF; resK = FF;
            }
            PH_BEGIN for (int rep_ = 0; rep_ < NREP(12); ++rep_, (rep_ < NREP(12) ? xcd_barrier(bar) : (void)0)) if (EN(12))
            { pg8::Gemm g{resA, resW, MP, D, resK, resK, 1 << 20, 0}; pg8::StaticOrder S; S.init(MP, D, G, bx);
              pg8::EpiResid E{X}; pg8::gemm_phase<pg8::EpiResid, true>(lds, g, S, E);
              pg8::sgemm_phase<pg8::EpiResid>(lds, resA + (size_t)MP * resK, resK, resW, resK, D, MP, vcu, G, E); }
            PH_END
            PH_BEGIN for (int rep_ = 0; rep_ < NREP(13); ++rep_, (rep_ < NREP(13) ? xcd_barrier(bar) : (void)0)) if (EN(13))
            {
                const float* lg = args.in[I_LNG] + (size_t)(layer * 2 + half) * D; const float* lb = args.in[I_LNB] + (size_t)(layer * 2 + half) * D;
                const bool fox_next = (layer == 1 && half == 1);
                LAS float* wfl = (LAS float*)lds;
                if (fox_next) {
                    for (int k = tid; k < D; k += 512) { const float* s = args.in[I_FOXWIN] + (size_t)k * 3088 + 3072; LAS float* d = wfl + ((k & 3) * 256 + (k >> 2)) * 20;
#pragma unroll
                        for (int q = 0; q < 4; ++q) *(LAS f32x4*)(d + 4 * q) = *(const f32x4*)(s + 4 * q); }
                    __syncthreads();
                }
                for (int m = gw; m < M; m += NGW) {
                    f32x4 v[4];
#pragma unroll
                    for (int jj = 0; jj < 4; ++jj) v[jj] = *(const f32x4*)(X + (size_t)m * D + 4 * lane + 256 * jj);
                    ln_row(v, lg, lb, lane);
#pragma unroll
                    for (int jj = 0; jj < 4; ++jj) *(f32x4*)(X + (size_t)m * D + 4 * lane + 256 * jj) = v[jj];
                    store_row_bf16(XN + (size_t)m * D, v, lane);
                    if (fox_next) {
                        f32x4 dacc[4] = {{0.f, 0.f, 0.f, 0.f}, {0.f, 0.f, 0.f, 0.f}, {0.f, 0.f, 0.f, 0.f}, {0.f, 0.f, 0.f, 0.f}};
#pragma unroll
                        for (int jj = 0; jj < 4; ++jj)
#pragma unroll
                            for (int e = 0; e < 4; ++e) { const LAS float* wr_ = wfl + (e * 256 + 64 * jj + lane) * 20; const float xv = v[jj][e];
#pragma unroll
                                for (int q = 0; q < 4; ++q) dacc[q] += xv * *(const LAS f32x4*)(wr_ + 4 * q); }
                        float mine = 0.f;
#pragma unroll
                        for (int q = 0; q < 4; ++q)
#pragma unroll
                            for (int e = 0; e < 4; ++e) { const float sfull = wave_sum(dacc[q][e]); if (lane == 4 * q + e) mine = sfull; }
                        if (lane < NH) { const float z = mine + args.in[I_FOXBF][lane]; const float lf = fminf(z, 0.f) - log1pf(__expf(-fabsf(z)));
                            LOGF[(size_t)m * NH + lane] = lf; OUT[O_FOXF + (size_t)m * NH + lane] = lf; }
                    }
                }
                if (fox_next) {
                    for (size_t i = (size_t)gw * 64 + lane; i < (size_t)2 * BS * PAST * (D / 8); i += (size_t)NGW * 64) {
                        const int which = (int)(i / ((size_t)BS * PAST * (D / 8))); const size_t e = i % ((size_t)BS * PAST * (D / 8)); const int b = (int)(e / (PAST * (D / 8))), pos = (int)((e / (D / 8)) % PAST), c = (int)(e % (D / 8)) * 8;
                        const float* src = args.in[which ? I_CFOXV : I_CFOXK] + e * 8;
                        const f32x4 v0 = *(const f32x4*)src, v1 = *(const f32x4*)(src + 4);
                        *(u32x4*)((which ? VF : KF) + (size_t)(MP + b * 1088 + pos) * D + c) = pg8::pack8(v0, v1);
                    }
                }
            }
            PH_END
        }
    }
#undef PH_BEGIN
#undef PH_END
}

extern "C" void kernel_launch(void* const* d_in, const int* in_sizes, int n_in, void* d_out, int out_size, void* d_ws, size_t ws_size, hipStream_t stream) {
    static int grid = 0;
    if (grid == 0) {
        if (n_in != 27 || in_sizes[0] != MP * D || (size_t)out_size != O_END || ws_size < WS_END) {
            fprintf(stderr, "kernel_launch: unexpected problem: n_in %d in0 %d out %d ws %zu (need %zu); nothing launched\n", n_in, n_in > 0 ? in_sizes[0] : -1, out_size, ws_size, (size_t)WS_END); grid = -1; return; }
        int dev = 0, cus = 0, per_cu = 0;
        if (hipGetDevice(&dev) != hipSuccess || hipDeviceGetAttribute(&cus, hipDeviceAttributeMultiprocessorCount, dev) != hipSuccess) { grid = -1; return; }
        if (hipFuncSetAttribute((const void*)fwd_megakernel, hipFuncAttributeMaxDynamicSharedMemorySize, LDS_BYTES) != hipSuccess) { fprintf(stderr, "kernel_launch: hipFuncSetAttribute failed\n"); grid = -1; return; }
        if (hipOccupancyMaxActiveBlocksPerMultiprocessor(&per_cu, (const void*)fwd_megakernel, 512, LDS_BYTES) != hipSuccess || per_cu < 1) {
            fprintf(stderr, "kernel_launch: occupancy query reports %d workgroups per CU; nothing launched\n", per_cu); (void)hipGetLastError(); grid = -1; return; }
        (void)hipGetLastError();
        grid = cus;
    }
    if (grid < 0) return;
    if (hipMemsetAsync((char*)d_ws + WS_CTL, 0, CTL_ZERO_BYTES, stream) != hipSuccess) { fprintf(stderr, "kernel_launch: memset failed\n"); return; }
    Args a{};
    for (int i = 0; i < 27; ++i) a.in[i] = (const float*)d_in[i];
    a.out = (float*)d_out; a.ws = (unsigned char*)d_ws;
#if MK_PER_PHASE
    for (int p = 0; p < NPH; ++p) { a.ph_lo = p; a.ph_hi = p + 1; hipLaunchKernelGGL(fwd_megakernel, dim3(grid), dim3(512), LDS_BYTES, stream, a); }
#else
    a.ph_lo = 0; a.ph_hi = NPH;
    hipLaunchKernelGGL(fwd_megakernel, dim3(grid), dim3(512), LDS_BYTES, stream, a);
#endif
    const hipError_t le = hipPeekAtLastError();
    if (le != hipSuccess) fprintf(stderr, "kernel_launch: launch failed: %s\n", hipGetErrorName(le));
}
```
